# Optimizing an MI355X kernel written in HIP

```python
import math
import jax, jax.numpy as jnp
from jax import lax
import numpy as np

D_MODEL = 1024
BATCH = 2
SEQ = 16384
DEPTH = 4

N_MEM = 256
HEAD_DIM = 64
N_MEM_HEADS = 4
MEM_WIDTH = N_MEM_HEADS * HEAD_DIM
CONV_WIDTH = D_MODEL - MEM_WIDTH
CONV_K = 3
N_Q_HEADS = CONV_WIDTH // HEAD_DIM
N_KV_HEADS = 4
GROUP = N_Q_HEADS // N_KV_HEADS
Q_WIDTH = N_Q_HEADS * HEAD_DIM
KV_WIDTH = N_KV_HEADS * HEAD_DIM
A_PROJ = 3 * CONV_WIDTH + MEM_WIDTH
B_PROJ = Q_WIDTH + MEM_WIDTH
WINDOW = 128
BLOCK = 128
REL_BUCKETS = 32
REL_MAX_DIST = 128
D_FF = ((8 * D_MODEL + 3 * 256 - 1) // (3 * 256)) * 256
N_A = DEPTH // 2
N_B = DEPTH - N_A
EPS = 1e-5

kernel_name = 'yoco_shortconv_swa_sink_hybrid'


def rmsnorm(x, g):
    x32 = x.astype(jnp.float32)
    y = x32 * lax.rsqrt(jnp.mean(x32 * x32, axis=-1, keepdims=True) + EPS)
    return (y * g.astype(jnp.float32)).astype(x.dtype)


def _rel_bucket(dist):
    max_exact = REL_BUCKETS // 2
    d = jnp.maximum(dist, 1).astype(jnp.float32)
    large = max_exact + (jnp.log(d / max_exact) / math.log(REL_MAX_DIST / max_exact)
                         * (REL_BUCKETS - max_exact)).astype(jnp.int32)
    large = jnp.minimum(large, REL_BUCKETS - 1)
    return jnp.where(dist < max_exact, dist, large)


def _band_geometry(n_blocks):
    qi = jnp.arange(BLOCK, dtype=jnp.int32)[:, None]
    kj = jnp.arange(2 * BLOCK, dtype=jnp.int32)[None, :]
    dist = qi + BLOCK - kj
    in_window = (dist >= 0) & (dist < WINDOW)
    first = (jnp.arange(n_blocks) == 0)[:, None, None]
    mask = in_window[None] & ~(first & (kj[None] < BLOCK))
    bucket = _rel_bucket(jnp.maximum(dist, 0))
    return mask, bucket


def _band(t):
    bsz, s = t.shape[0], t.shape[1]
    tb = t.reshape(bsz, s // BLOCK, BLOCK, N_KV_HEADS, HEAD_DIM)
    prev = jnp.concatenate([jnp.zeros_like(tb[:, :1]), tb[:, :-1]], axis=1)
    return jnp.concatenate([prev, tb], axis=2)


def _short_conv(u, b_gate, c_gate, w):
    v = c_gate * u
    s = v.shape[1]
    vp = jnp.pad(v, ((0, 0), (CONV_K - 1, 0), (0, 0)))
    conv = w[0] * vp[:, 0:s] + w[1] * vp[:, 1:s + 1] + w[2] * vp[:, 2:s + 2]
    return b_gate * conv


def _swa_sinks(q, k_band, v_band, sinks, rel_bias, mask, bucket):
    bsz, s, _ = q.shape
    nb = s // BLOCK
    qb = q.reshape(bsz, nb, BLOCK, N_KV_HEADS, GROUP, HEAD_DIM)
    logits = jnp.einsum('bnqhgd,bnjhd->bnhgqj', qb, k_band).astype(jnp.float32) * (HEAD_DIM ** -0.5)
    bias = jnp.transpose(rel_bias.astype(jnp.float32)[bucket], (2, 0, 1))
    bias = bias.reshape(N_KV_HEADS, GROUP, BLOCK, 2 * BLOCK)
    logits = jnp.where(mask[None, :, None, None], logits + bias, -jnp.inf)
    sink = sinks.astype(jnp.float32).reshape(N_KV_HEADS, GROUP, 1, 1)
    m = jnp.maximum(jnp.max(logits, axis=-1, keepdims=True), sink)
    p = jnp.exp(logits - m)
    denom = jnp.sum(p, axis=-1, keepdims=True) + jnp.exp(sink - m)
    probs = (p / denom).astype(v_band.dtype)
    out = jnp.einsum('bnhgqj,bnjhd->bnqhgd', probs, v_band)
    return out.reshape(bsz, s, Q_WIDTH)


def _mem_attention(q_mem, mem_k, mem_v):
    bsz, s = q_mem.shape[0], q_mem.shape[1]
    logits = jnp.einsum('bshd,bmhd->bhsm', q_mem, mem_k).astype(jnp.float32) * (HEAD_DIM ** -0.5)
    probs = jax.nn.softmax(logits, axis=-1).astype(mem_v.dtype)
    return jnp.einsum('bhsm,bmhd->bshd', probs, mem_v).reshape(bsz, s, MEM_WIDTH)


def setup_inputs(seed: int = 0) -> dict:
    key = jax.random.key(seed)
    ks = jax.random.split(key, 20)

    def nrm(k, shape, scale):
        return jax.random.normal(k, shape, jnp.float32) * scale

    def gain(k, shape):
        return 1.0 + nrm(k, shape, 0.05)

    return {
        'x': nrm(ks[0], (BATCH, SEQ, D_MODEL), 1.0),
        'mem': nrm(ks[1], (BATCH, N_MEM, D_MODEL), 1.0),
        'norm_mix': gain(ks[2], (DEPTH, D_MODEL)),
        'norm_ffn': gain(ks[3], (DEPTH, D_MODEL)),
        'a_w_in': nrm(ks[4], (N_A, D_MODEL, A_PROJ), D_MODEL ** -0.5),
        'a_conv_w': nrm(ks[5], (N_A, CONV_K, CONV_WIDTH), CONV_K ** -0.5),
        'a_w_out': nrm(ks[6], (N_A, CONV_WIDTH + MEM_WIDTH, D_MODEL), (CONV_WIDTH + MEM_WIDTH) ** -0.5),
        'kv_norm': gain(ks[7], (D_MODEL,)),
        'w_kv': nrm(ks[8], (D_MODEL, 2 * KV_WIDTH), D_MODEL ** -0.5),
        'b_w_q': nrm(ks[9], (N_B, D_MODEL, B_PROJ), D_MODEL ** -0.5),
        'b_sinks': nrm(ks[10], (N_B, N_Q_HEADS), 0.5),
        'b_w_out': nrm(ks[11], (N_B, Q_WIDTH + MEM_WIDTH, D_MODEL), (Q_WIDTH + MEM_WIDTH) ** -0.5),
        'rel_bias': nrm(ks[12], (REL_BUCKETS, N_Q_HEADS), 0.5),
        'mem_norm': gain(ks[13], (D_MODEL,)),
        'w_mem_kv': nrm(ks[14], (DEPTH, D_MODEL, 2 * MEM_WIDTH), D_MODEL ** -0.5),
        'w_gate': nrm(ks[15], (DEPTH, D_MODEL, D_FF), D_MODEL ** -0.5),
        'w_up': nrm(ks[16], (DEPTH, D_MODEL, D_FF), D_MODEL ** -0.5),
        'w_down': nrm(ks[17], (DEPTH, D_FF, D_MODEL), D_FF ** -0.5),
        'final_norm': gain(ks[18], (D_MODEL,)),
    }


def reference(x, mem, norm_mix, norm_ffn, a_w_in, a_conv_w, a_w_out, kv_norm, w_kv,
              b_w_q, b_sinks, b_w_out, rel_bias, mem_norm, w_mem_kv, w_gate, w_up, w_down,
              final_norm):
    bsz, s, _ = x.shape
    mask, bucket = _band_geometry(s // BLOCK)
    mem_n = rmsnorm(mem, mem_norm)
    k_band = None
    v_band = None
    for i in range(DEPTH):
        if i == N_A:
            kv = rmsnorm(x, kv_norm) @ w_kv
            k, v = jnp.split(kv, 2, axis=-1)
            k_band = _band(k.reshape(bsz, s, N_KV_HEADS, HEAD_DIM))
            v_band = _band(v.reshape(bsz, s, N_KV_HEADS, HEAD_DIM))
        mem_kv = mem_n @ w_mem_kv[i]
        mk, mv = jnp.split(mem_kv, 2, axis=-1)
        mk = mk.reshape(bsz, N_MEM, N_MEM_HEADS, HEAD_DIM)
        mv = mv.reshape(bsz, N_MEM, N_MEM_HEADS, HEAD_DIM)
        h = rmsnorm(x, norm_mix[i])
        if i < N_A:
            proj = h @ a_w_in[i]
            u, b_gate, c_gate, q_mem = jnp.split(
                proj, [CONV_WIDTH, 2 * CONV_WIDTH, 3 * CONV_WIDTH], axis=-1)
            y_tok = _short_conv(u, b_gate, c_gate, a_conv_w[i])
            w_out = a_w_out[i]
        else:
            j = i - N_A
            proj = h @ b_w_q[j]
            q, q_mem = jnp.split(proj, [Q_WIDTH], axis=-1)
            y_tok = _swa_sinks(q, k_band, v_band, b_sinks[j], rel_bias, mask, bucket)
            w_out = b_w_out[j]
        y_mem = _mem_attention(q_mem.reshape(bsz, s, N_MEM_HEADS, HEAD_DIM), mk, mv)
        x = x + jnp.concatenate([y_tok, y_mem], axis=-1) @ w_out
        h = rmsnorm(x, norm_ffn[i])
        x = x + (jax.nn.silu(h @ w_gate[i]) * (h @ w_up[i])) @ w_down[i]
    return rmsnorm(x, final_norm)
```

```cpp
#include <hip/hip_runtime.h>
#include <hip/hip_cooperative_groups.h>
#include <cstdio>
#include <cstdint>
namespace cg = cooperative_groups;
namespace pg8 {
#define PG8_LAS __attribute__((address_space(3)))
typedef unsigned short bf16_t;
typedef short bf16x8 __attribute__((ext_vector_type(8)));
typedef float f32x4 __attribute__((ext_vector_type(4)));
typedef unsigned u32x4 __attribute__((ext_vector_type(4)));
constexpr int BM = 256, BK = 64, HALF = 128, HTB = HALF * BK * 2  , STAGE_BYTES = 8 * HTB, NXCD = 8, WGM = 4;

__host__ __device__ __forceinline__ int lds_byte(int r, int c) { const int st = (r >> 4) * 2 + (c >> 5), rr = r & 15, cc = c & 31, ob = rr * 64 + cc * 2; return st * 1024 + (ob ^ (((ob >> 9) & 1) << 5)); }
__host__ __device__ __forceinline__ void stage_rc(int b, int& R, int& C) { const int st = b / 1024, sb = b % 1024, swz = sb ^ (((sb >> 9) & 1) << 5); R = (st >> 1) * 16 + swz / 64; C = (st & 1) * 32 + (swz % 64) / 2; }
__host__ __device__ __forceinline__ int perm32(int rho) { const int n = rho >> 4, i = rho & 15; return 8 * (i >> 2) + 4 * n + (i & 3); }

struct Unit { int pm, pn, ui; };
struct Gemm { const bf16_t* A; const bf16_t* Bt; int M, N, K; };

struct StaticOrder {
    int nM, nN, nwg, G, c;
    __host__ __device__ void init(int M, int N, int G_, int c_) { nM = M / BM; nN = N / BM; nwg = nM * nN; G = G_; c = c_; }
    __host__ __device__ bool next(int i, Unit& u) const {
        const long L = (long)i * G + c; if (L >= nwg) return false;
        int wgid = (int)L; { const int q = nwg / NXCD, r = nwg % NXCD, xcd = wgid % NXCD, off = wgid / NXCD; wgid = (xcd < r ? xcd * (q + 1) : r * (q + 1) + (xcd - r) * q) + off; }
        const int nig = WGM * nN, gid = wgid / nig, fm = gid * WGM, gsz = (nM - fm) < WGM ? (nM - fm) : WGM;
        u.pm = fm + ((wgid % nig) % gsz); u.pn = (wgid % nig) / gsz; u.ui = i; return true;
    }
    __device__ __forceinline__ void a_ready(const Unit&) const {}
    __device__ __forceinline__ void done(const Unit&) const {}
};
typedef float f32x2_t __attribute__((ext_vector_type(2))); typedef __bf16 bf16x2_t __attribute__((ext_vector_type(2)));
__device__ __forceinline__ unsigned cvt_pk_bf16(float lo, float hi) { f32x2_t v = {lo, hi}; bf16x2_t b = __builtin_convertvector(v, bf16x2_t); return __builtin_bit_cast(unsigned, b); }
typedef float f32x2 __attribute__((ext_vector_type(2)));
typedef unsigned u32x2 __attribute__((ext_vector_type(2)));
constexpr int DMODEL = 1024;
__device__ __forceinline__ float row_rstd(const float* ssqp, int row) {
    const f32x4* p = (const f32x4*)(ssqp + (size_t)row * 16);
    const f32x4 a = p[0], b = p[1], c = p[2], d = p[3];
    const f32x4 s = (a + b) + (c + d);
    const float t = (s[0] + s[1]) + (s[2] + s[3]);
    return __builtin_amdgcn_rsqf(t * (1.0f / 1024.0f) + 1e-5f);
}
constexpr int RSTAB_OFF = 132096;
template <class Sched> __device__ __forceinline__ void fill_rstd(PG8_LAS unsigned char* lds, const float* ssqp, const Sched& S, int tid) {
    PG8_LAS float* tab = (PG8_LAS float*)(lds + RSTAB_OFF); Unit u; const int row = tid >> 1, half = tid & 1;
    for (int i = 0; S.next(i, u); ++i) { const f32x4* p = (const f32x4*)(ssqp + (size_t)(u.pm * BM + row) * 16 + half * 8); const f32x4 a = p[0], b = p[1], s4 = a + b; float s = (s4[0] + s4[1]) + (s4[2] + s4[3]);
        s += __shfl_xor(s, 1); if (half == 0) tab[i * 256 + row] = __builtin_amdgcn_rsqf(s * (1.0f / 1024.0f) + 1e-5f); }
    __syncthreads();
}
__device__ __forceinline__ u32x4 pack8(f32x4 v0, f32x4 v1) { u32x4 w; w.x = cvt_pk_bf16(v0[0], v0[1]); w.y = cvt_pk_bf16(v0[2], v0[3]); w.z = cvt_pk_bf16(v1[0], v1[1]); w.w = cvt_pk_bf16(v1[2], v1[3]); return w; }
__device__ __forceinline__ unsigned short f2bf1(float f) { unsigned u = __builtin_bit_cast(unsigned, f); return (unsigned short)((u + 0x7fffu + ((u >> 16) & 1u)) >> 16); }

struct EpiAIn {
    static constexpr bool PERM = true, AFTER_DRAIN = false;
    bf16_t *V, *BG, *QM; const PG8_LAS float* rstab; float qscale;
    __device__ __forceinline__ void operator()(const f32x4 (&acc)[2][2][4][2], const Unit& u, int wr, int wc, int fr, int fq) const {
        const int row0 = u.pm * BM + wr * 64 + fr, cl = wc * 32 + 8 * fq; const PG8_LAS float* rt = rstab + u.ui * 256 + wr * 64 + fr;
        if (u.pn < 6) {
#pragma unroll
            for (int ai = 0; ai < 2; ++ai)
#pragma unroll
                for (int m = 0; m < 4; ++m) { const int row = row0 + ai * HALF + m * 16; const float r = rt[ai * HALF + m * 16], r2 = r * r;
                    *(u32x4*)(V + (size_t)row * 768 + u.pn * 128 + cl) = pack8(acc[ai][0][m][0] * acc[ai][1][m][0] * r2, acc[ai][0][m][1] * acc[ai][1][m][1] * r2); }
        } else if (u.pn < 9) {
#pragma unroll
            for (int ai = 0; ai < 2; ++ai)
#pragma unroll
                for (int m = 0; m < 4; ++m) { const int row = row0 + ai * HALF + m * 16; const float r = rt[ai * HALF + m * 16];
#pragma unroll
                    for (int bj = 0; bj < 2; ++bj) *(u32x4*)(BG + (size_t)row * 768 + (u.pn - 6) * 256 + bj * HALF + cl) = pack8(acc[ai][bj][m][0] * r, acc[ai][bj][m][1] * r); }
        } else {
#pragma unroll
            for (int ai = 0; ai < 2; ++ai)
#pragma unroll
                for (int m = 0; m < 4; ++m) { const int row = row0 + ai * HALF + m * 16; const float r = rt[ai * HALF + m * 16] * qscale;
#pragma unroll
                    for (int bj = 0; bj < 2; ++bj) *(u32x4*)(QM + (size_t)row * 256 + bj * HALF + cl) = pack8(acc[ai][bj][m][0] * r, acc[ai][bj][m][1] * r); }
        }
    }
};
struct EpiRowScale {
    static constexpr bool PERM = true, AFTER_DRAIN = false;
    bf16_t* O; int ldc; const PG8_LAS float* rstab; float scale; size_t pn_stride; bf16_t* KO; int pn0;
    __device__ __forceinline__ void operator()(const f32x4 (&acc)[2][2][4][2], const Unit& u, int wr, int wc, int fr, int fq) const {
        const int row0 = u.pm * BM + wr * 64 + fr, cl = wc * 32 + 8 * fq; const bool isk = u.pn < pn0;
        bf16_t* ob = isk ? KO + cl : O + (size_t)(u.pn - pn0) * pn_stride + cl; const int ld = isk ? 256 : ldc; const float sc = isk ? 1.0f : scale;
        const PG8_LAS float* rt = rstab + u.ui * 256 + wr * 64 + fr;
#pragma unroll
        for (int ai = 0; ai < 2; ++ai)
#pragma unroll
            for (int m = 0; m < 4; ++m) { const int row = row0 + ai * HALF + m * 16; const float r = rstab ? rt[ai * HALF + m * 16] * sc : sc;
#pragma unroll
                for (int bj = 0; bj < 2; ++bj) *(u32x4*)(ob + (size_t)row * ld + bj * HALF) = pack8(acc[ai][bj][m][0] * r, acc[ai][bj][m][1] * r); }
    }
};
struct EpiVT {
    static constexpr bool PERM = true, AFTER_DRAIN = true;
    bf16_t* O; int ld; const float* ssqp; size_t pm_stride, pn_stride;
    __device__ __forceinline__ void fused(f32x4 (&acc)[2][2][4][2], const Unit& u, int wr, int wc, int fr, int fq, PG8_LAS unsigned char* lds, int wid, int lane) const {
        PG8_LAS float* rs = (PG8_LAS float*)lds;
        { const int t = wid * 64 + lane, tok = t >> 1, half = t & 1; float r = 1.0f;
          if (ssqp) { const f32x4* p = (const f32x4*)(ssqp + (size_t)(u.pn * BM + tok) * 16 + half * 8); const f32x4 a = p[0], b = p[1], s4 = a + b; float s = (s4[0] + s4[1]) + (s4[2] + s4[3]);
              s += __shfl_xor(s, 1); r = __builtin_amdgcn_rsqf(s * (1.0f / 1024.0f) + 1e-5f); }
          if (half == 0) rs[tok] = r; }
        asm volatile("s_waitcnt lgkmcnt(0)" ::: "memory"); __builtin_amdgcn_s_barrier(); asm volatile("" ::: "memory");
        const int rl0 = wr * 64 + fr, cl = wc * 32 + 8 * fq; bf16_t* ob = O + (size_t)u.pm * pm_stride + (size_t)u.pn * pn_stride + cl;
#pragma unroll
        for (int bj = 0; bj < 2; ++bj) {
            const f32x4 s0 = *(const PG8_LAS f32x4*)(rs + bj * HALF + cl), s1 = *(const PG8_LAS f32x4*)(rs + bj * HALF + cl + 4);
#pragma unroll
            for (int ai = 0; ai < 2; ++ai)
#pragma unroll
                for (int m = 0; m < 4; ++m) *(u32x4*)(ob + (size_t)(rl0 + ai * HALF + m * 16) * ld + bj * HALF) = pack8(acc[ai][bj][m][0] * s0, acc[ai][bj][m][1] * s1);
        }
        asm volatile("s_waitcnt lgkmcnt(0)" ::: "memory"); __builtin_amdgcn_s_barrier(); asm volatile("" ::: "memory");
    }
};
struct EpiSwiglu {
    static constexpr bool PERM = true, AFTER_DRAIN = false;
    bf16_t* H; const PG8_LAS float* rstab;
    __device__ __forceinline__ void operator()(const f32x4 (&acc)[2][2][4][2], const Unit& u, int wr, int wc, int fr, int fq) const {
        const int row0 = u.pm * BM + wr * 64 + fr, cl = u.pn * 128 + wc * 32 + 8 * fq; const PG8_LAS float* rt = rstab + u.ui * 256 + wr * 64 + fr;
#pragma unroll
        for (int ai = 0; ai < 2; ++ai)
#pragma unroll
            for (int m = 0; m < 4; ++m) { const int row = row0 + ai * HALF + m * 16; const float r = rt[ai * HALF + m * 16], nr = r * -1.4426950408889634f, r2 = r * r;
                f32x4 hv[2];
#pragma unroll
                for (int n = 0; n < 2; ++n) { const f32x4 ag = acc[ai][0][m][n], au = acc[ai][1][m][n]; const f32x4 t = ag * nr, gu = (ag * au) * r2; f32x4 d;
#pragma unroll
                    for (int j = 0; j < 4; ++j) d[j] = __builtin_amdgcn_rcpf(1.0f + __builtin_amdgcn_exp2f(t[j]));
                    hv[n] = gu * d; }
                *(u32x4*)(H + (size_t)row * 2816 + cl) = pack8(hv[0], hv[1]); }
    }
};
struct EpiRes {
    static constexpr bool PERM = true, AFTER_DRAIN = false;
    bf16_t* xb; float* ssqp;
    __device__ __forceinline__ void operator()(const f32x4 (&acc)[2][2][4][2], const Unit& u, int wr, int wc, int fr, int fq) const {
        const int row0 = u.pm * BM + wr * 64 + fr, cl = u.pn * BM + wc * 32 + 8 * fq;
#pragma unroll
        for (int ai = 0; ai < 2; ++ai)
#pragma unroll
            for (int m = 0; m < 4; ++m) { const int row = row0 + ai * HALF + m * 16; bf16_t* xp = xb + (size_t)row * DMODEL + cl; float q = 0.f;
#pragma unroll
                for (int bj = 0; bj < 2; ++bj) { const u32x4 o = *(const u32x4*)(xp + bj * HALF);
                    const f32x4 b0 = {__builtin_bit_cast(float, o.x << 16), __builtin_bit_cast(float, o.x & 0xffff0000u), __builtin_bit_cast(float, o.y << 16), __builtin_bit_cast(float, o.y & 0xffff0000u)};
                    const f32x4 b1 = {__builtin_bit_cast(float, o.z << 16), __builtin_bit_cast(float, o.z & 0xffff0000u), __builtin_bit_cast(float, o.w << 16), __builtin_bit_cast(float, o.w & 0xffff0000u)};
                    const f32x4 x0 = b0 + acc[ai][bj][m][0], x1 = b1 + acc[ai][bj][m][1];
                    *(u32x4*)(xp + bj * HALF) = pack8(x0, x1);
                    q += (x0[0] * x0[0] + x0[1] * x0[1]) + (x0[2] * x0[2] + x0[3] * x0[3]) + (x1[0] * x1[0] + x1[1] * x1[1]) + (x1[2] * x1[2] + x1[3] * x1[3]); }
                q += __shfl_xor(q, 16); q += __shfl_xor(q, 32);
                if (fq == 0) ssqp[(size_t)row * 16 + u.pn * 4 + wc] = q; }
    }
};
template <class Epi, class Sched, bool ALIGN_EPI = false, bool SP2 = false>
__device__ __forceinline__ void gemm_phase(PG8_LAS unsigned char* lds, const Gemm g, const Sched& S, const Epi& E, const int tid) {
    const int wid = __builtin_amdgcn_readfirstlane(tid >> 6), lane = tid & 63, wr = wid >> 2, wc = wid & 3, fr = lane & 15, fq = lane >> 4;
    const int K = g.K, nt = K / BK;
    unsigned voffA[2], voffB[2];
#pragma unroll
    for (int i = 0; i < 2; ++i) { int R, C; stage_rc(tid * 16 + i * 8192, R, C); const int Rb = Epi::PERM ? ((R & ~31) + perm32(R & 31)) : R;
        voffA[i] = (unsigned)(R * K + C) * 2u; voffB[i] = (unsigned)(Rb * K + C) * 2u; }
    const size_t kstep = (size_t)(BK * 2);
    const size_t hstep = (size_t)HALF * K * 2;
    const size_t tstep = 2 * hstep;
    const unsigned ldsw = (unsigned)wid * 1024u;
    const int aoff = lds_byte(wr * 64 + fr, fq * 8), boff = lds_byte(wc * 32 + fr, fq * 8);
#define PG8_SA(b, h) (((b) * 2 + (h)) * HTB)
#define PG8_SB(b, h) ((4 + (b) * 2 + (h)) * HTB)
#define PG8_STAGE(bufoff, gbase, voff) do { _Pragma("unroll") for (int _i = 0; _i < 2; ++_i) \
        __builtin_amdgcn_global_load_lds((const unsigned*)((const char*)(gbase) + (voff)[_i]), (PG8_LAS unsigned*)(lds + (bufoff) + ldsw + _i * 8192), 16, 0, 0); } while (0)
#define PG8_LDA(dst, b, h) do { _Pragma("unroll") for (int m = 0; m < 4; ++m) _Pragma("unroll") for (int k = 0; k < 2; ++k) dst[m][k] = *(const PG8_LAS bf16x8*)(lds + PG8_SA(b, h) + aoff + m * 2048 + k * 1024); } while (0)
#define PG8_LDB(dst, b, h) do { _Pragma("unroll") for (int n = 0; n < 2; ++n) _Pragma("unroll") for (int k = 0; k < 2; ++k) dst[n][k] = *(const PG8_LAS bf16x8*)(lds + PG8_SB(b, h) + boff + n * 2048 + k * 1024); } while (0)
#define PG8_MMA(ai, bj, At, Bt) do { __builtin_amdgcn_s_setprio(1); _Pragma("unroll") for (int m = 0; m < 4; ++m) _Pragma("unroll") for (int n = 0; n < 2; ++n) _Pragma("unroll") for (int k = 0; k < 2; ++k) \
        acc[ai][bj][m][n] = __builtin_amdgcn_mfma_f32_16x16x32_bf16(Bt[n][k], At[m][k], acc[ai][bj][m][n], 0, 0, 0); __builtin_amdgcn_s_setprio(0); } while (0)
#define PG8_WAIT_V(n) asm volatile("s_waitcnt vmcnt(" #n ")" ::: "memory")
#define PG8_WAIT_L(n) asm volatile("s_waitcnt lgkmcnt(" #n ")" ::: "memory")
#define PG8_BAR __builtin_amdgcn_s_barrier()
#define PG8_SCHED __builtin_amdgcn_sched_barrier(0)
    Unit cur, nxt; int ui = 0;
    if (!S.next(0, cur)) return;
    f32x4 acc[2][2][4][2];
#pragma unroll
    for (int a = 0; a < 2; ++a)
#pragma unroll
        for (int b = 0; b < 2; ++b)
#pragma unroll
            for (int m = 0; m < 4; ++m)
#pragma unroll
                for (int n = 0; n < 2; ++n) acc[a][b][m][n] = (f32x4){0.f, 0.f, 0.f, 0.f};
    bf16x8 At[4][2], B0[2][2], B1[2][2];
    const char* cA = (const char*)g.A + (size_t)cur.pm * tstep; const char* cB = (const char*)g.Bt + (size_t)cur.pn * tstep;
    S.a_ready(cur);
    if constexpr (SP2) {
        PG8_STAGE(PG8_SB(0, 0), cB, voffB); PG8_STAGE(PG8_SB(0, 1), cB + hstep, voffB); PG8_STAGE(PG8_SA(0, 0), cA, voffA); PG8_STAGE(PG8_SA(0, 1), cA + hstep, voffA);
        if (wr == 1) PG8_BAR;
        PG8_WAIT_V(2); PG8_BAR;
        PG8_STAGE(PG8_SB(1, 0), cB + kstep, voffB); PG8_STAGE(PG8_SA(1, 0), cA + kstep, voffA); PG8_STAGE(PG8_SB(1, 1), cB + hstep + kstep, voffB);
        PG8_WAIT_V(6); PG8_BAR;
    } else {
        PG8_STAGE(PG8_SB(0, 0), cB, voffB); PG8_STAGE(PG8_SA(0, 0), cA, voffA); PG8_STAGE(PG8_SB(0, 1), cB + hstep, voffB); PG8_STAGE(PG8_SA(0, 1), cA + hstep, voffA);
        if (wr == 1) PG8_BAR;
        PG8_WAIT_V(4); PG8_BAR;
        PG8_STAGE(PG8_SB(1, 0), cB + kstep, voffB); PG8_STAGE(PG8_SA(1, 0), cA + kstep, voffA); PG8_STAGE(PG8_SB(1, 1), cB + hstep + kstep, voffB);
        PG8_WAIT_V(6); PG8_BAR;
    }
    for (;;) {
        const bool has_next = S.next(ui + 1, nxt);
        const char* nA = has_next ? (const char*)g.A + (size_t)nxt.pm * tstep : cA; const char* nB = has_next ? (const char*)g.Bt + (size_t)nxt.pn * tstep : cB;
        for (int t = 0; t < nt; t += 2) {
            const bool last = (t == nt - 2);
            const char* a1 = cA + (size_t)(t + 1) * kstep;
            const char* a2 = last ? nA : cA + (size_t)(t + 2) * kstep; const char* b2 = last ? nB : cB + (size_t)(t + 2) * kstep;
            const char* a3 = a2 + kstep; const char* b3 = b2 + kstep;
            if (last && has_next) S.a_ready(nxt);
            if constexpr (SP2) {
            PG8_LDB(B0, 0, 0); PG8_LDB(B1, 0, 1); PG8_SCHED; PG8_LDA(At, 0, 0); PG8_STAGE(PG8_SA(1, 1), a1 + hstep, voffA);
            PG8_WAIT_V(8); PG8_WAIT_L(0); PG8_BAR; PG8_MMA(0, 0, At, B0); PG8_MMA(0, 1, At, B1); PG8_BAR; PG8_SCHED;
            PG8_LDA(At, 0, 1); PG8_STAGE(PG8_SB(0, 0), b2, voffB); PG8_STAGE(PG8_SB(0, 1), b2 + hstep, voffB); PG8_STAGE(PG8_SA(0, 0), a2, voffA);
            PG8_WAIT_V(8); PG8_WAIT_L(0); PG8_BAR; PG8_MMA(1, 0, At, B0); PG8_MMA(1, 1, At, B1); PG8_BAR; PG8_SCHED;
            PG8_LDB(B0, 1, 0); PG8_LDB(B1, 1, 1); PG8_SCHED; PG8_LDA(At, 1, 0); PG8_STAGE(PG8_SA(0, 1), a2 + hstep, voffA);
            PG8_WAIT_V(8); PG8_WAIT_L(0); PG8_BAR; PG8_MMA(0, 0, At, B0); PG8_MMA(0, 1, At, B1); PG8_BAR; PG8_SCHED;
            PG8_LDA(At, 1, 1); PG8_STAGE(PG8_SB(1, 0), b3, voffB); PG8_STAGE(PG8_SB(1, 1), b3 + hstep, voffB); PG8_STAGE(PG8_SA(1, 0), a3, voffA);
            PG8_WAIT_V(8); PG8_WAIT_L(0); PG8_BAR; PG8_MMA(1, 0, At, B0); PG8_MMA(1, 1, At, B1); PG8_BAR; PG8_SCHED;
            } else {
            PG8_LDB(B0, 0, 0); PG8_SCHED; PG8_LDA(At, 0, 0); PG8_STAGE(PG8_SA(1, 1), a1 + hstep, voffA);
            PG8_WAIT_L(8); PG8_BAR; PG8_WAIT_L(0); PG8_MMA(0, 0, At, B0); PG8_BAR; PG8_SCHED;
            PG8_LDB(B1, 0, 1); PG8_STAGE(PG8_SB(0, 0), b2, voffB);
            PG8_BAR; PG8_WAIT_L(0); PG8_MMA(0, 1, At, B1); PG8_BAR;
            PG8_LDA(At, 0, 1); PG8_STAGE(PG8_SA(0, 0), a2, voffA);
            PG8_BAR; PG8_WAIT_L(0); PG8_MMA(1, 0, At, B0); PG8_BAR; PG8_SCHED;
            PG8_STAGE(PG8_SB(0, 1), b2 + hstep, voffB);
            PG8_WAIT_V(6); PG8_BAR; PG8_MMA(1, 1, At, B1); PG8_BAR;
            PG8_LDB(B0, 1, 0); PG8_SCHED; PG8_LDA(At, 1, 0); PG8_STAGE(PG8_SA(0, 1), a2 + hstep, voffA);
            PG8_WAIT_L(8); PG8_BAR; PG8_WAIT_L(0); PG8_MMA(0, 0, At, B0); PG8_BAR; PG8_SCHED;
            PG8_LDB(B1, 1, 1); PG8_STAGE(PG8_SB(1, 0), b3, voffB);
            PG8_BAR; PG8_WAIT_L(0); PG8_MMA(0, 1, At, B1); PG8_BAR;
            PG8_LDA(At, 1, 1); PG8_STAGE(PG8_SA(1, 0), a3, voffA);
            PG8_BAR; PG8_WAIT_L(0); PG8_MMA(1, 0, At, B0); PG8_BAR; PG8_SCHED;
            PG8_STAGE(PG8_SB(1, 1), b3 + hstep, voffB);
            PG8_WAIT_V(6); PG8_BAR; PG8_MMA(1, 1, At, B1); PG8_BAR;
            }
        }
        if constexpr (ALIGN_EPI) { if (wr == 0) PG8_BAR; }
        if constexpr (!Epi::AFTER_DRAIN) { E(acc, cur, wr, wc, fr, fq); S.done(cur); }
        if (!has_next) break;
#pragma unroll
        for (int a = 0; a < 2; ++a)
#pragma unroll
            for (int b = 0; b < 2; ++b)
#pragma unroll
                for (int m = 0; m < 4; ++m)
#pragma unroll
                    for (int n = 0; n < 2; ++n) acc[a][b][m][n] = (f32x4){0.f, 0.f, 0.f, 0.f};
        cur = nxt; cA = nA; cB = nB; ++ui;
        if constexpr (ALIGN_EPI) { if (wr == 1) PG8_BAR; }
    }
    PG8_WAIT_V(0);
    if constexpr (!ALIGN_EPI) { if (wr == 0) PG8_BAR; }
    PG8_BAR;
    if constexpr (Epi::AFTER_DRAIN) { E.fused(acc, cur, wr, wc, fr, fq, lds, wid, lane); S.done(cur); }
#undef PG8_SA
#undef PG8_SB
#undef PG8_STAGE
#undef PG8_LDA
#undef PG8_LDB
#undef PG8_MMA
#undef PG8_WAIT_V
#undef PG8_WAIT_L
#undef PG8_BAR
#undef PG8_SCHED
}
}

constexpr int BATCH = 2, SEQ = 16384, D = 1024, M = BATCH * SEQ, NMEM = 256, DFF = 2816, CONVW = 768, APROJ = 2560;
constexpr int NWAVES = 8, NTHREADS = 512;
constexpr float LOG2E = 1.4426950408889634f, QSCALE = 0.125f * LOG2E, EPS = 1e-5f;

constexpr size_t MiB = 1u << 20;
constexpr size_t WS_SSQ = 0;
constexpr size_t WS_MEMN = 2 * MiB;
constexpr size_t WS_MK = 3 * MiB;
constexpr size_t WS_MVT = 4 * MiB;
constexpr size_t WS_WAIN = 5 * MiB;
constexpr size_t WS_WAOUT = 15 * MiB;
constexpr size_t WS_WKV = 19 * MiB;
constexpr size_t WS_WBQ = 20 * MiB;
constexpr size_t WS_WBOUT = 24 * MiB;
constexpr size_t WS_WMEMKV = 28 * MiB;
constexpr size_t WS_WUP = 32 * MiB;
constexpr size_t WS_WDOWN = 76 * MiB;
constexpr size_t WS_XB = 98 * MiB;
constexpr size_t WS_KB = 162 * MiB;
constexpr size_t WS_VT = 178 * MiB;
constexpr size_t WS_H = 194 * MiB;
constexpr size_t WS_V = WS_H;
constexpr size_t WS_BG = WS_H + 48 * MiB;
constexpr size_t WS_QM = WS_H + 96 * MiB;
constexpr size_t WS_Y = WS_H + 112 * MiB;
constexpr size_t WS_Q = WS_H;
constexpr size_t WS_CTL = 370 * MiB, CTL_BYTES = 65536;
constexpr size_t WS_END = 371 * MiB;

constexpr int LDS_BYTES = 147456;
#define LAS __attribute__((address_space(3)))
typedef unsigned short bf16;
typedef unsigned v4u __attribute__((ext_vector_type(4)));
typedef unsigned v2u __attribute__((ext_vector_type(2)));
typedef float f32x4 __attribute__((ext_vector_type(4)));
typedef float f32x16 __attribute__((ext_vector_type(16)));
typedef short bf16x8 __attribute__((ext_vector_type(8)));
typedef short s16x4 __attribute__((ext_vector_type(4)));
#define LDS_WAIT() asm volatile("s_waitcnt lgkmcnt(0)" ::: "memory")
__device__ __forceinline__ unsigned f2bf(float f) { unsigned u = __builtin_bit_cast(unsigned, f); return (u + 0x7fffu + ((u >> 16) & 1u)) >> 16; }
__device__ __forceinline__ unsigned pk2(float lo, float hi) { return pg8::cvt_pk_bf16(lo, hi); }
__device__ __forceinline__ float bflo(unsigned u) { return __builtin_bit_cast(float, u << 16); }
__device__ __forceinline__ float bfhi(unsigned u) { return __builtin_bit_cast(float, u & 0xffff0000u); }
__device__ __forceinline__ float wave_sum(float v) {
#pragma unroll
    for (int o = 1; o < 64; o <<= 1) v += __shfl_xor(v, o);
    return v;
}

struct Args { const float* in[19]; float* out; unsigned char* ws; };
typedef const Args __attribute__((address_space(4)))* CArgsP;
__device__ __forceinline__ CArgsP kargs() { CArgsP p = (CArgsP)__builtin_amdgcn_kernarg_segment_ptr(); asm volatile("" : "+s"(p)); return p; }
enum { I_X = 0, I_MEM, I_NORM_MIX, I_NORM_FFN, I_A_W_IN, I_A_CONV_W, I_A_W_OUT, I_KV_NORM, I_W_KV, I_B_W_Q, I_B_SINKS, I_B_W_OUT, I_REL_BIAS, I_MEM_NORM, I_W_MEM_KV, I_W_GATE, I_W_UP, I_W_DOWN, I_FINAL_NORM };

template <bool HAS_GAIN>
__device__ __forceinline__ void transpose_item(const float* W, int K, int Nsrc, const float* gain, bf16* WT, int dst_row0, int k0, int n0, LAS float* scr, int lane) {
    const int c = lane & 7;
    f32x4 g0 = {1.f, 1.f, 1.f, 1.f}, g1 = {1.f, 1.f, 1.f, 1.f};
    if (HAS_GAIN) { g0 = *(const f32x4*)(gain + k0 + 8 * c); g1 = *(const f32x4*)(gain + k0 + 8 * c + 4); }
#pragma unroll
    for (int i = 0; i < 32; ++i) { const int kk = 2 * i + (lane >> 5); scr[kk * 33 + (lane & 31)] = W[(size_t)(k0 + kk) * Nsrc + n0 + (lane & 31)]; }
    LDS_WAIT(); asm volatile("" ::: "memory");
#pragma unroll
    for (int j = 0; j < 4; ++j) { const int n = (lane >> 3) + 8 * j; const LAS float* s = scr + (8 * c) * 33 + n;
        v4u o; o.x = pk2(s[0 * 33] * g0[0], s[1 * 33] * g0[1]); o.y = pk2(s[2 * 33] * g0[2], s[3 * 33] * g0[3]); o.z = pk2(s[4 * 33] * g1[0], s[5 * 33] * g1[1]); o.w = pk2(s[6 * 33] * g1[2], s[7 * 33] * g1[3]);
        *(v4u*)(WT + (size_t)(dst_row0 + n) * K + k0 + 8 * c) = o; }
    LDS_WAIT(); asm volatile("" ::: "memory");
}
__device__ __forceinline__ void prologue(LAS unsigned char* lds, int gw, int NGW, int wave, int lane) {
    const CArgsP ka = kargs(); unsigned char* ws = ka->ws;
    LAS float* scr = (LAS float*)(lds + wave * 16384);
    constexpr int N_AIN = 16 * 80, N_SQ = 16 * 32, N_KV = 16 * 16, N_FF = 16 * 88, N_DN = 44 * 32;
    constexpr int NITEMS = 2 * N_AIN + 2 * N_SQ + N_KV + 2 * N_SQ + 2 * N_SQ + 4 * N_KV + 4 * N_FF + 4 * N_FF + 4 * N_DN;
    for (int it = gw; it < NITEMS; it += NGW) {
        int r = it;
        if (r < 2 * N_AIN) { const int l = r / N_AIN; r %= N_AIN; const int kb = r / 80, nb = r % 80, n0 = 32 * nb;
            int dst; if (n0 < 768) dst = 256 * (n0 / 128) + (n0 % 128); else if (n0 < 1536) dst = 1536 + (n0 - 768); else if (n0 < 2304) dst = 256 * ((n0 - 1536) / 128) + 128 + ((n0 - 1536) % 128); else dst = n0;
            transpose_item<true>(ka->in[I_A_W_IN] + (size_t)l * D * APROJ, D, APROJ, ka->in[I_NORM_MIX] + l * D, (bf16*)(ws + WS_WAIN) + (size_t)l * APROJ * D, dst, 64 * kb, n0, scr, lane); continue; }
        r -= 2 * N_AIN;
        if (r < 2 * N_SQ) { const int l = r / N_SQ; r %= N_SQ; const int kb = r / 32, nb = r % 32;
            transpose_item<false>(ka->in[I_A_W_OUT] + (size_t)l * D * D, D, D, nullptr, (bf16*)(ws + WS_WAOUT) + (size_t)l * D * D, 32 * nb, 64 * kb, 32 * nb, scr, lane); continue; }
        r -= 2 * N_SQ;
        if (r < N_KV) { const int kb = r / 16, nb = r % 16;
            transpose_item<true>(ka->in[I_W_KV], D, 512, ka->in[I_KV_NORM], (bf16*)(ws + WS_WKV), (nb < 8 ? 256 + 32 * nb : 32 * (nb - 8)), 64 * kb, 32 * nb, scr, lane); continue; }
        r -= N_KV;
        if (r < 2 * N_SQ) { const int l = r / N_SQ; r %= N_SQ; const int kb = r / 32, nb = r % 32;
            transpose_item<true>(ka->in[I_B_W_Q] + (size_t)l * D * D, D, D, ka->in[I_NORM_MIX] + (2 + l) * D, (bf16*)(ws + WS_WBQ) + (size_t)l * D * D, 32 * nb, 64 * kb, 32 * nb, scr, lane); continue; }
        r -= 2 * N_SQ;
        if (r < 2 * N_SQ) { const int l = r / N_SQ; r %= N_SQ; const int kb = r / 32, nb = r % 32;
            transpose_item<false>(ka->in[I_B_W_OUT] + (size_t)l * D * D, D, D, nullptr, (bf16*)(ws + WS_WBOUT) + (size_t)l * D * D, 32 * nb, 64 * kb, 32 * nb, scr, lane); continue; }
        r -= 2 * N_SQ;
        if (r < 4 * N_KV) { const int l = r / N_KV; r %= N_KV; const int kb = r / 16, nb = r % 16;
            transpose_item<false>(ka->in[I_W_MEM_KV] + (size_t)l * D * 512, D, 512, nullptr, (bf16*)(ws + WS_WMEMKV), (nb < 8 ? 256 * l + 32 * nb : 1024 + 256 * l + 32 * (nb - 8)), 64 * kb, 32 * nb, scr, lane); continue; }
        r -= 4 * N_KV;
        if (r < 8 * N_FF) { const int which = r / (4 * N_FF); r %= 4 * N_FF; const int l = r / N_FF; r %= N_FF; const int kb = r / 88, nb = r % 88, n0 = 32 * nb;
            const int dst = 256 * (n0 / 128) + 128 * which + (n0 % 128);
            transpose_item<true>((which ? ka->in[I_W_UP] : ka->in[I_W_GATE]) + (size_t)l * D * DFF, D, DFF, ka->in[I_NORM_FFN] + l * D, (bf16*)(ws + WS_WUP) + (size_t)l * 2 * DFF * D, dst, 64 * kb, n0, scr, lane); continue; }
        r -= 8 * N_FF;
        { const int l = r / N_DN; r %= N_DN; const int kb = r / 32, nb = r % 32;
            transpose_item<false>(ka->in[I_W_DOWN] + (size_t)l * DFF * D, DFF, D, nullptr, (bf16*)(ws + WS_WDOWN) + (size_t)l * D * DFF, 32 * nb, 64 * kb, 32 * nb, scr, lane); }
    }
    const float* x = ka->in[I_X]; bf16* XB = (bf16*)(ws + WS_XB); float* ssqp = (float*)(ws + WS_SSQ);
    for (int m0 = gw; m0 < M; m0 += 4 * NGW) {
        f32x4 v[4][4];
#pragma unroll
        for (int q = 0; q < 4; ++q) { const f32x4* xr = (const f32x4*)(x + (size_t)(m0 + q * NGW) * D) + lane;
#pragma unroll
            for (int j = 0; j < 4; ++j) v[q][j] = xr[64 * j]; }
#pragma unroll
        for (int q = 0; q < 4; ++q) { const int m = m0 + q * NGW; float s = 0.f;
#pragma unroll
            for (int j = 0; j < 4; ++j) s += (v[q][j].x * v[q][j].x + v[q][j].y * v[q][j].y) + (v[q][j].z * v[q][j].z + v[q][j].w * v[q][j].w);
            s = wave_sum(s);
            unsigned long long* o8 = (unsigned long long*)(XB + (size_t)m * D) + lane;
#pragma unroll
            for (int j = 0; j < 4; ++j) o8[64 * j] = (unsigned long long)pk2(v[q][j].x, v[q][j].y) | ((unsigned long long)pk2(v[q][j].z, v[q][j].w) << 32);
            if (lane < 16) ssqp[(size_t)m * 16 + lane] = lane == 0 ? s : 0.f; }
    }
    const float* mem = ka->in[I_MEM]; const float* mg = ka->in[I_MEM_NORM]; bf16* MEMN = (bf16*)(ws + WS_MEMN);
    for (int m = gw; m < BATCH * NMEM; m += NGW) {
        const f32x4* xr = (const f32x4*)(mem + (size_t)m * D) + lane; const f32x4* gr = (const f32x4*)mg + lane; f32x4 v[4]; float s = 0.f;
#pragma unroll
        for (int j = 0; j < 4; ++j) { v[j] = xr[64 * j]; s += (v[j].x * v[j].x + v[j].y * v[j].y) + (v[j].z * v[j].z + v[j].w * v[j].w); }
        const float rstd = 1.0f / sqrtf(wave_sum(s) * (1.0f / D) + EPS);
        unsigned long long* o8 = (unsigned long long*)(MEMN + (size_t)m * D) + lane;
#pragma unroll
        for (int j = 0; j < 4; ++j) { const f32x4 g = gr[64 * j]; const f32x4 y = v[j] * rstd * g; o8[64 * j] = (unsigned long long)pk2(y.x, y.y) | ((unsigned long long)pk2(y.z, y.w) << 32); }
    }
}

__device__ __forceinline__ unsigned cvtpk(float lo, float hi) { return pg8::cvt_pk_bf16(lo, hi); }
__device__ __forceinline__ void softmax_block(f32x16& S, float& m, float& l, f32x16& o0, f32x16& o1, bf16x8& p0, bf16x8& p1) {
    float bm = fmaxf(S[0], S[1]);
#pragma unroll
    for (int i = 2; i < 16; ++i) bm = fmaxf(bm, S[i]);
    bm = fmaxf(bm, __shfl_xor(bm, 32));
    const float mn = fmaxf(m, bm);
    const float alpha = __builtin_amdgcn_exp2f(m - mn);
    m = mn;
    float sum = 0.f;
#pragma unroll
    for (int i = 0; i < 16; ++i) { S[i] = __builtin_amdgcn_exp2f(S[i] - mn); sum += S[i]; }
    l = l * alpha + sum;
#pragma unroll
    for (int i = 0; i < 16; ++i) { o0[i] *= alpha; o1[i] *= alpha; }
    v4u w0, w1;
    w0.x = cvtpk(S[0], S[1]); w0.y = cvtpk(S[2], S[3]); w0.z = cvtpk(S[4], S[5]); w0.w = cvtpk(S[6], S[7]);
    w1.x = cvtpk(S[8], S[9]); w1.y = cvtpk(S[10], S[11]); w1.z = cvtpk(S[12], S[13]); w1.w = cvtpk(S[14], S[15]);
    p0 = __builtin_bit_cast(bf16x8, w0); p1 = __builtin_bit_cast(bf16x8, w1);
}
__device__ __forceinline__ void attn_store(const f32x16& o0, const f32x16& o1, float l, bf16* yrow, int hi) {
    l += __shfl_xor(l, 32);
    const float inv = 1.0f / l;
#pragma unroll
    for (int g = 0; g < 4; ++g) {
        v2u w; w.x = pk2(o0[4 * g] * inv, o0[4 * g + 1] * inv); w.y = pk2(o0[4 * g + 2] * inv, o0[4 * g + 3] * inv); *(v2u*)(yrow + 8 * g + 4 * hi) = w;
        v2u z; z.x = pk2(o1[4 * g] * inv, o1[4 * g + 1] * inv); z.y = pk2(o1[4 * g + 2] * inv, o1[4 * g + 3] * inv); *(v2u*)(yrow + 32 + 8 * g + 4 * hi) = z;
    }
}
constexpr int KIMG_STRIDE = 144, VIMG_STRIDE = 528, KIMG_BYTES = 256 * KIMG_STRIDE, VIMG_BYTES = 64 * VIMG_STRIDE, TAB_OFF = KIMG_BYTES + VIMG_BYTES;
__device__ __forceinline__ void mem_stage(LAS unsigned char* lds, const bf16* MK, const bf16* MVT, int layer, int b, int h, int tid) {
    const bf16* ksrc = MK + ((size_t)layer * 512 + b * 256) * 256 + h * 64;
    for (int i = tid; i < 256 * 8; i += NTHREADS) { const int key = i >> 3, c = i & 7; *(LAS v4u*)(lds + key * KIMG_STRIDE + c * 16) = *(const v4u*)(ksrc + (size_t)key * 256 + c * 8); }
    const bf16* vsrc = MVT + ((size_t)(layer * 2 + b) * 256 + h * 64) * 256;
    for (int i = tid; i < 64 * 32; i += NTHREADS) { const int d = i >> 5, c = i & 31; *(LAS v4u*)(lds + KIMG_BYTES + d * VIMG_STRIDE + c * 16) = *(const v4u*)(vsrc + (size_t)d * 256 + c * 8); }
    __syncthreads();
}
__device__ __forceinline__ void mem_attn_unit(LAS unsigned char* lds, const bf16* q, int ldq, bf16* y, int ldy, int lane) {
    const int r = lane & 31, hi = lane >> 5;
    bf16x8 qf[4];
#pragma unroll
    for (int s = 0; s < 4; ++s) qf[s] = *(const bf16x8*)(q + (size_t)r * ldq + 16 * s + 8 * hi);
    float m = -1e30f, l = 0.f; f32x16 o0 = {}, o1 = {};
    for (int kb = 0; kb < 8; ++kb) {
        f32x16 S = {};
#pragma unroll
        for (int s = 0; s < 4; ++s) { const bf16x8 kf = *(const LAS bf16x8*)(lds + (kb * 32 + r) * KIMG_STRIDE + (16 * s + 8 * hi) * 2); S = __builtin_amdgcn_mfma_f32_32x32x16_bf16(kf, qf[s], S, 0, 0, 0); }
        bf16x8 p0, p1; softmax_block(S, m, l, o0, o1, p0, p1);
#pragma unroll
        for (int s = 0; s < 2; ++s) {
            const bf16x8 pb = s ? p1 : p0;
#pragma unroll
            for (int db = 0; db < 2; ++db) {
                const LAS unsigned char* vp = lds + KIMG_BYTES + (db * 32 + r) * VIMG_STRIDE + (kb * 32 + 16 * s + 4 * hi) * 2;
                const s16x4 a = *(const LAS s16x4*)vp, c = *(const LAS s16x4*)(vp + 16);
                const bf16x8 vf = (bf16x8){a[0], a[1], a[2], a[3], c[0], c[1], c[2], c[3]};
                if (db == 0) o0 = __builtin_amdgcn_mfma_f32_32x32x16_bf16(vf, pb, o0, 0, 0, 0); else o1 = __builtin_amdgcn_mfma_f32_32x32x16_bf16(vf, pb, o1, 0, 0, 0);
            }
        }
    }
    attn_store(o0, o1, l, y + (size_t)r * ldy, hi);
}
__device__ __forceinline__ void mem_attn_phase(LAS unsigned char* lds, const bf16* MK, const bf16* MVT, int layer, const bf16* Q, int ldq, int qcol0, bf16* Y, int tid, int wave, int lane) {
    const int G = gridDim.x, bh = blockIdx.x & 7, b = bh >> 2, h = bh & 3, slot = blockIdx.x >> 3, nslots = (G - bh + 7) >> 3;
    mem_stage(lds, MK, MVT, layer, b, h, tid);
    for (int g = slot * NWAVES + wave; g < SEQ / 32; g += nslots * NWAVES) {
        const size_t row0 = (size_t)b * SEQ + (size_t)g * 32;
        mem_attn_unit(lds, Q + row0 * ldq + qcol0 + h * 64, ldq, Y + row0 * D + CONVW + h * 64, D, lane);
    }
    __syncthreads();
}

__device__ __forceinline__ void conv_phase(const bf16* V, const bf16* BG, const float* cw, bf16* Y, int gtid, int nthreads) {
    constexpr int NCH = CONVW / 8;
    for (int idx = gtid; idx < (M / 4) * NCH; idx += nthreads) {
        const int rg = idx / NCH, ch = idx % NCH, c0 = ch * 8, t0 = rg * 4, tl = t0 % SEQ;
        float w0[8], w1[8], w2[8];
#pragma unroll
        for (int j = 0; j < 8; j += 4) { const f32x4 a = *(const f32x4*)(cw + c0 + j), b = *(const f32x4*)(cw + CONVW + c0 + j), c = *(const f32x4*)(cw + 2 * CONVW + c0 + j);
#pragma unroll
            for (int e = 0; e < 4; ++e) { w0[j + e] = a[e]; w1[j + e] = b[e]; w2[j + e] = c[e]; } }
        float vm2[8], vm1[8];
        if (tl != 0) { const v4u a = *(const v4u*)(V + (size_t)(t0 - 2) * CONVW + c0), b = *(const v4u*)(V + (size_t)(t0 - 1) * CONVW + c0);
#pragma unroll
            for (int e = 0; e < 4; ++e) { vm2[2 * e] = bflo(a[e]); vm2[2 * e + 1] = bfhi(a[e]); vm1[2 * e] = bflo(b[e]); vm1[2 * e + 1] = bfhi(b[e]); } }
        else {
#pragma unroll
            for (int e = 0; e < 8; ++e) { vm2[e] = 0.f; vm1[e] = 0.f; } }
#pragma unroll
        for (int rr = 0; rr < 4; ++rr) {
            const v4u vv = *(const v4u*)(V + (size_t)(t0 + rr) * CONVW + c0), gg = *(const v4u*)(BG + (size_t)(t0 + rr) * CONVW + c0);
            float v[8], g[8], yv[8];
#pragma unroll
            for (int e = 0; e < 4; ++e) { v[2 * e] = bflo(vv[e]); v[2 * e + 1] = bfhi(vv[e]); g[2 * e] = bflo(gg[e]); g[2 * e + 1] = bfhi(gg[e]); }
#pragma unroll
            for (int e = 0; e < 8; ++e) { yv[e] = g[e] * (w0[e] * vm2[e] + w1[e] * vm1[e] + w2[e] * v[e]); vm2[e] = vm1[e]; vm1[e] = v[e]; }
            v4u o; o.x = pk2(yv[0], yv[1]); o.y = pk2(yv[2], yv[3]); o.z = pk2(yv[4], yv[5]); o.w = pk2(yv[6], yv[7]);
            *(v4u*)(Y + (size_t)(t0 + rr) * D + c0) = o;
        }
    }
}

constexpr int SK_STRIDE = 144, SK_BYTES = 384 * SK_STRIDE, SV_STRIDE = 776, SV_BYTES = 64 * SV_STRIDE, STAB_OFF = SK_BYTES + SV_BYTES;
static_assert(STAB_OFF + 12 * 128 * 4 <= 131072, "swa LDS map");
__device__ __forceinline__ void swa_unit(LAS unsigned char* lds, const LAS float* tab, const bf16* Q, bf16* Y, size_t row0, int tl0, int w, int qh, float sink2, int lane) {
    const int r = lane & 31, hi = lane >> 5;
    bf16x8 qf[4];
#pragma unroll
    for (int s = 0; s < 4; ++s) qf[s] = *(const bf16x8*)(Q + (row0 + r) * D + qh * 64 + 16 * s + 8 * hi);
    float m = sink2, l = hi == 0 ? 1.0f : 0.0f; f32x16 o0 = {}, o1 = {};
    const LAS float* tb = tab + qh * 128;
    const int kb0 = tl0 >= 128 ? 0 : (128 - tl0) >> 5;
    for (int kb = kb0; kb < 5; ++kb) {
        const int j0 = 32 * w + 32 * kb;
        f32x16 S = {};
#pragma unroll
        for (int s = 0; s < 4; ++s) { const bf16x8 kf = *(const LAS bf16x8*)(lds + (j0 + r) * SK_STRIDE + (16 * s + 8 * hi) * 2); S = __builtin_amdgcn_mfma_f32_32x32x16_bf16(kf, qf[s], S, 0, 0, 0); }
#pragma unroll
        for (int i = 0; i < 16; ++i) { const int krow = (i & 3) + 8 * (i >> 2) + 4 * hi; const int dist = 128 - 32 * kb + r - krow;
            S[i] = ((unsigned)dist < 128u) ? S[i] + tb[dist & 127] : -1e30f; }
        bf16x8 p0, p1; softmax_block(S, m, l, o0, o1, p0, p1);
#pragma unroll
        for (int s = 0; s < 2; ++s) {
            const bf16x8 pb = s ? p1 : p0;
#pragma unroll
            for (int db = 0; db < 2; ++db) {
                const LAS unsigned char* vp = lds + SK_BYTES + (db * 32 + r) * SV_STRIDE + (j0 + 16 * s + 4 * hi) * 2;
                const s16x4 a = *(const LAS s16x4*)vp, c = *(const LAS s16x4*)(vp + 16);
                const bf16x8 vf = (bf16x8){a[0], a[1], a[2], a[3], c[0], c[1], c[2], c[3]};
                if (db == 0) o0 = __builtin_amdgcn_mfma_f32_32x32x16_bf16(vf, pb, o0, 0, 0, 0); else o1 = __builtin_amdgcn_mfma_f32_32x32x16_bf16(vf, pb, o1, 0, 0, 0);
            }
        }
    }
    attn_store(o0, o1, l, Y + (row0 + r) * D + qh * 64, hi);
}
__device__ __forceinline__ void swa_phase(LAS unsigned char* lds, const float* rel_bias, const float* sinks, const bf16* Q, const bf16* KB, const bf16* VT, bf16* Y, int tid, int wave, int lane) {
    LAS float* tab = (LAS float*)(lds + STAB_OFF);
    for (int i = tid; i < 12 * 128; i += NTHREADS) { const int h = i >> 7, d = i & 127;
        int bucket = d; if (d >= 16) { bucket = 16 + (int)(log2f((float)d * (1.0f / 16.0f)) * (16.0f / 3.0f)); bucket = bucket > 31 ? 31 : bucket; }
        tab[i] = rel_bias[bucket * 12 + h] * LOG2E; }
    const int G = gridDim.x;
    for (int task = blockIdx.x; task < 4 * (M / 256); task += G) {
        const int kvh = task & 3, chunk = task >> 2, b = chunk / (SEQ / 256), tlc = (chunk % (SEQ / 256)) * 256;
        __syncthreads();
        const int jlo = tlc == 0 ? 128 : 0;
        const bf16* ksrc = KB + ((size_t)b * SEQ + tlc - 128) * 256 + kvh * 64;
        for (int i = tid; i < 384 * 8; i += NTHREADS) { const int j = i >> 3, c = i & 7; if (j >= jlo) *(LAS v4u*)(lds + j * SK_STRIDE + c * 16) = *(const v4u*)(ksrc + (size_t)j * 256 + c * 8); }
        const bf16* vsrc = VT + (size_t)(kvh * 64) * M + (size_t)b * SEQ + tlc - 128;
        for (int i = tid; i < 64 * 96; i += NTHREADS) { const int d = i / 96, c = i % 96; if (c * 4 >= jlo) *(LAS v2u*)(lds + SK_BYTES + d * SV_STRIDE + c * 8) = *(const v2u*)(vsrc + (size_t)d * M + c * 4); }
        __syncthreads();
        const int tl0 = tlc + wave * 32; const size_t row0 = (size_t)b * SEQ + tl0;
        for (int g = 0; g < 3; ++g) { const int qh = kvh * 3 + g; swa_unit(lds, tab, Q, Y, row0, tl0, wave, qh, sinks[qh] * LOG2E, lane); }
    }
    __syncthreads();
}

__device__ __forceinline__ void final_phase(const bf16* XBs, float* out, const float* g, int gw, int NGW, int lane) {
    const f32x4* gr = (const f32x4*)g + lane;
    for (int m0 = gw; m0 < M; m0 += 4 * NGW) {
        v2u v[4][4];
#pragma unroll
        for (int q = 0; q < 4; ++q) { const v2u* xr = (const v2u*)(XBs + (size_t)(m0 + q * NGW) * D) + lane;
#pragma unroll
            for (int j = 0; j < 4; ++j) v[q][j] = xr[64 * j]; }
#pragma unroll
        for (int q = 0; q < 4; ++q) { f32x4* orow = (f32x4*)(out + (size_t)(m0 + q * NGW) * D) + lane; f32x4 f[4]; float s = 0.f;
#pragma unroll
            for (int j = 0; j < 4; ++j) { f[j] = (f32x4){bflo(v[q][j].x), bfhi(v[q][j].x), bflo(v[q][j].y), bfhi(v[q][j].y)}; s += (f[j].x * f[j].x + f[j].y * f[j].y) + (f[j].z * f[j].z + f[j].w * f[j].w); }
            const float rstd = 1.0f / sqrtf(wave_sum(s) * (1.0f / D) + EPS);
#pragma unroll
            for (int j = 0; j < 4; ++j) orow[64 * j] = f[j] * rstd * gr[64 * j]; }
    }
}

#define XB_TMO      128
#define XB_XCNT(j)  (256  + 64 * (j))
#define XB_XSUB(j)  (1280 + 64 * (j))
#define XB_XGEN(j)  (2304 + 64 * (j))
#define XB_TOP      3328
#define XB_TOPGEN   3392
#define XCD_BAR_WORDS 3456
#define XB_SPIN_CAP (1u << 18)

__device__ __forceinline__ unsigned xb_ld(unsigned* p)              { return __hip_atomic_load(p, __ATOMIC_RELAXED, __HIP_MEMORY_SCOPE_AGENT); }
__device__ __forceinline__ unsigned xb_add(unsigned* p, unsigned v) { return __hip_atomic_fetch_add(p, v, __ATOMIC_RELAXED, __HIP_MEMORY_SCOPE_AGENT); }
__device__ __forceinline__ unsigned xb_xcc_id() { return (unsigned)__builtin_amdgcn_s_getreg((3 << 11) | 20) & 0xFu; }
#define XB_SPIN(cond, bar) do { unsigned _sp = 0; while (cond) { __builtin_amdgcn_s_sleep(1); \
    if ((++_sp & 255u) == 0u) { if (xb_ld(&(bar)[XB_TMO])) break; if (_sp > XB_SPIN_CAP) { atomicAdd(&(bar)[XB_TMO], 1u); break; } } } } while (0)

struct XcdBarrier {
    unsigned* bar; unsigned x;
    volatile LAS unsigned* st;
};

__device__ __forceinline__ XcdBarrier xcd_barrier_post(unsigned* bar, volatile LAS unsigned* st) {
    XcdBarrier b; b.bar = bar; b.x = xb_xcc_id(); b.st = st;
    if (threadIdx.x == 0) (void)xb_add(&bar[XB_XCNT(b.x)], 1u);
    return b;
}
__device__ __forceinline__ void xcd_barrier_complete(unsigned* bar, unsigned x, unsigned& nloc, unsigned& nx) {
    const unsigned G = gridDim.x * gridDim.y * gridDim.z;
    unsigned sum, cnt, mine, sp = 0u;
    for (;;) {
        sum = 0u; cnt = 0u; mine = 0u;
#pragma unroll
        for (unsigned j = 0; j < 16; ++j) { const unsigned c = xb_ld(&bar[XB_XCNT(j)]); sum += c; cnt += (c > 0u) ? 1u : 0u; mine = (j == x) ? c : mine; }
        if (sum == G) break;
        __builtin_amdgcn_s_sleep(1);
        if ((++sp & 255u) == 0u) { if (xb_ld(&bar[XB_TMO])) break; if (sp > XB_SPIN_CAP) { atomicAdd(&bar[XB_TMO], 1u); break; } }
    }
    nloc = mine > 0u ? mine : 1u; nx = cnt > 0u ? cnt : 1u;
}

__device__ __forceinline__ void xcd_barrier(const XcdBarrier& b) {
    asm volatile("s_waitcnt vmcnt(0)" ::: "memory");
    __syncthreads();
    if (threadIdx.x == 0) {
        unsigned* bar = b.bar;
        __builtin_amdgcn_s_waitcnt(0);
        unsigned nloc = b.st[0], nx = b.st[1];
        if (nloc == 0u) { xcd_barrier_complete(bar, b.x, nloc, nx); b.st[0] = nloc; b.st[1] = nx; }
        const unsigned old = xb_add(&bar[XB_XSUB(b.x)], 1u);
        const unsigned gen = old / nloc;
        if (old + 1u == (gen + 1u) * nloc) {
            __builtin_amdgcn_fence(__ATOMIC_RELEASE, "agent");
            asm volatile("s_waitcnt vmcnt(0)" ::: "memory");
            const unsigned og = xb_add(&bar[XB_TOP], 1u);
            const unsigned tg = og / nx;
            if (og + 1u == (tg + 1u) * nx) xb_add(&bar[XB_TOPGEN], 1u);
            else XB_SPIN(xb_ld(&bar[XB_TOPGEN]) == tg, bar);
            __builtin_amdgcn_fence(__ATOMIC_ACQUIRE, "agent");
            xb_add(&bar[XB_XGEN(b.x)], 1u);
            asm volatile("s_waitcnt vmcnt(0)" ::: "memory");
        } else {
            XB_SPIN(xb_ld(&bar[XB_XGEN(b.x)]) == gen, bar);
            __builtin_amdgcn_fence(__ATOMIC_ACQUIRE, "agent");
            asm volatile("s_waitcnt vmcnt(0)" ::: "memory");
        }
    }
    __syncthreads();
}

#define GRID_SYNC() do { XcdBarrier b_; b_.bar = (unsigned*)(kargs()->ws + WS_CTL); b_.x = xb_xcc_id(); b_.st = (volatile LAS unsigned*)(lds + 131072) + 8; xcd_barrier(b_); } while (0)
enum StepType { ST_AIN = 0, ST_MIXA, ST_RES, ST_UP, ST_KVQ, ST_ATTB, ST_FINAL };
__global__ void __launch_bounds__(NTHREADS, 2) yoco_fwd(Args a) {
    extern __shared__ __attribute__((aligned(16))) unsigned char lds_raw[];
    cg::grid_group grid = cg::this_grid();
    LAS unsigned char* lds = (LAS unsigned char*)lds_raw;
    const int tid = threadIdx.x, lane = tid & 63, wave = __builtin_amdgcn_readfirstlane(tid >> 6), G = gridDim.x;
    const int gw = blockIdx.x * NWAVES + wave, NGW = G * NWAVES;
    { unsigned char* ws = kargs()->ws;

    volatile LAS unsigned* MISC = (volatile LAS unsigned*)(lds + 131072);
    if (tid < 64) MISC[tid] = 0u;
    __syncthreads();
    (void)xcd_barrier_post((unsigned*)(ws + WS_CTL), MISC + 8);

    prologue(lds, gw, NGW, wave, lane);
    GRID_SYNC(); }

    for (int step = 0; step < 21; ++step) {
        int type, layer, sub = 0;
        if (step < 20) { layer = step / 5; const int k = step % 5; sub = (k == 4);
            type = (k == 0) ? (layer < 2 ? ST_AIN : ST_KVQ) : (k == 1) ? (layer < 2 ? ST_MIXA : ST_ATTB) : (k == 3) ? ST_UP : ST_RES; }
        else { type = ST_FINAL; layer = 3; }
        int tidv = threadIdx.x; asm volatile("" : "+v"(tidv));
        const int lanev = tidv & 63, wavev = __builtin_amdgcn_readfirstlane(tidv >> 6);
        const CArgsP ka = kargs(); unsigned char* ws = ka->ws;
        float* ssqp = (float*)(ws + WS_SSQ); bf16* XB = (bf16*)(ws + WS_XB); bf16* Hb = (bf16*)(ws + WS_H); bf16* Yb = (bf16*)(ws + WS_Y); bf16* MK = (bf16*)(ws + WS_MK); bf16* MVT = (bf16*)(ws + WS_MVT);
        switch (type) {
        case ST_AIN: {
            if (layer == 0) {
                { pg8::Gemm g{(const bf16*)(ws + WS_MEMN), (const bf16*)(ws + WS_WMEMKV), 512, 1024, D}; pg8::StaticOrder S; S.init(512, 1024, G, (int)blockIdx.x);
                  pg8::EpiRowScale E{MK, 256, (const LAS float*)nullptr, 1.0f, (size_t)512 * 256, nullptr, 0};
                  pg8::gemm_phase<pg8::EpiRowScale, pg8::StaticOrder, true, true>(lds, g, S, E, tidv); }
                { pg8::Gemm g{(const bf16*)(ws + WS_WMEMKV) + (size_t)1024 * D, (const bf16*)(ws + WS_MEMN), 1024, 512, D}; pg8::StaticOrder S; S.init(1024, 512, G, (int)((blockIdx.x + G - 8) % G));
                  pg8::EpiVT E{MVT, 256, nullptr, (size_t)2 * 65536, (size_t)65536};
                  pg8::gemm_phase<pg8::EpiVT, pg8::StaticOrder, true, true>(lds, g, S, E, tidv); }
            }
            pg8::Gemm g{XB, (const bf16*)(ws + WS_WAIN) + (size_t)layer * APROJ * D, M, APROJ, D}; pg8::StaticOrder S; S.init(M, APROJ, G, (int)blockIdx.x);
            pg8::fill_rstd(lds, ssqp, S, tidv);
            pg8::EpiAIn E{(bf16*)(ws + WS_V), (bf16*)(ws + WS_BG), (bf16*)(ws + WS_QM), (const LAS float*)(lds + pg8::RSTAB_OFF), QSCALE};
            pg8::gemm_phase<pg8::EpiAIn, pg8::StaticOrder, true, true>(lds, g, S, E, tidv);
        } break;
        case ST_MIXA: {
            conv_phase((const bf16*)(ws + WS_V), (const bf16*)(ws + WS_BG), ka->in[I_A_CONV_W] + (size_t)layer * 3 * CONVW, Yb, blockIdx.x * NTHREADS + tidv, G * NTHREADS);
            mem_attn_phase(lds, MK, MVT, layer, (const bf16*)(ws + WS_QM), 256, 0, Yb, tidv, wavev, lanev);
        } break;
        case ST_RES: {
            const bf16* A = sub ? Hb : Yb; const int K = sub ? DFF : D;
            const bf16* Bt = sub ? (const bf16*)(ws + WS_WDOWN) + (size_t)layer * D * DFF : (layer < 2 ? (const bf16*)(ws + WS_WAOUT) + (size_t)layer * D * D : (const bf16*)(ws + WS_WBOUT) + (size_t)(layer - 2) * D * D);
            pg8::Gemm g{A, Bt, M, D, K}; pg8::StaticOrder S; S.init(M, D, G, (int)blockIdx.x);
            pg8::EpiRes E{XB, ssqp};
            pg8::gemm_phase<pg8::EpiRes, pg8::StaticOrder, true, true>(lds, g, S, E, tidv);
        } break;
        case ST_UP: {
            pg8::Gemm g{XB, (const bf16*)(ws + WS_WUP) + (size_t)layer * 2 * DFF * D, M, 2 * DFF, D}; pg8::StaticOrder S; S.init(M, 2 * DFF, G, (int)blockIdx.x);
            pg8::fill_rstd(lds, ssqp, S, tidv);
            pg8::EpiSwiglu E{Hb, (const LAS float*)(lds + pg8::RSTAB_OFF)};
            pg8::gemm_phase<pg8::EpiSwiglu, pg8::StaticOrder, true, true>(lds, g, S, E, tidv);
        } break;
        case ST_KVQ: {
            if (layer == 2) {
                pg8::Gemm g{(const bf16*)(ws + WS_WKV), XB, 256, M, D}; pg8::StaticOrder S; S.init(256, M, G, (int)((blockIdx.x + G - 128) % G));
                pg8::EpiVT E{(bf16*)(ws + WS_VT), M, ssqp, (size_t)0, (size_t)256};
                pg8::gemm_phase<pg8::EpiVT, pg8::StaticOrder, true, true>(lds, g, S, E, tidv);
            }
            const int pn0 = layer == 2 ? 1 : 0;
            pg8::Gemm g{XB, layer == 2 ? (const bf16*)(ws + WS_WKV) + (size_t)256 * D : (const bf16*)(ws + WS_WBQ) + (size_t)D * D, M, D + 256 * pn0, D}; pg8::StaticOrder S; S.init(M, D + 256 * pn0, G, (int)blockIdx.x);
            pg8::fill_rstd(lds, ssqp, S, tidv);
            pg8::EpiRowScale E{(bf16*)(ws + WS_Q), D, (const LAS float*)(lds + pg8::RSTAB_OFF), QSCALE, (size_t)256, (bf16*)(ws + WS_KB), pn0};
            pg8::gemm_phase<pg8::EpiRowScale, pg8::StaticOrder, true, true>(lds, g, S, E, tidv);
        } break;
        case ST_ATTB: {
            swa_phase(lds, ka->in[I_REL_BIAS], ka->in[I_B_SINKS] + (layer - 2) * 12, (const bf16*)(ws + WS_Q), (const bf16*)(ws + WS_KB), (const bf16*)(ws + WS_VT), Yb, tidv, wavev, lanev);
            mem_attn_phase(lds, MK, MVT, layer, (const bf16*)(ws + WS_Q), D, CONVW, Yb, tidv, wavev, lanev);
        } break;
        default: {
            final_phase(XB, ka->out, ka->in[I_FINAL_NORM], blockIdx.x * NWAVES + wavev, NGW, lanev);
        } break;
        }
        if (step < 20) GRID_SYNC();
    }
    if (kargs()->out == nullptr) grid.sync();
}

extern "C" void kernel_launch(void* const* d_in, const int* in_sizes, int n_in, void* d_out, int out_size, void* d_ws, size_t ws_size, hipStream_t stream) {
    static int grid = 0;
    if (grid == 0) {
        if (n_in != 19 || out_size != M * D || ws_size < WS_END) { fprintf(stderr, "kernel_launch: unexpected shapes (n_in %d out %d ws %zu)\n", n_in, out_size, ws_size); grid = -1; return; }
        int dev = 0, cus = 0, per_cu = 0;
        if (hipGetDevice(&dev) != hipSuccess || hipDeviceGetAttribute(&cus, hipDeviceAttributeMultiprocessorCount, dev) != hipSuccess) { grid = -1; return; }
        if (hipFuncSetAttribute((const void*)yoco_fwd, hipFuncAttributeMaxDynamicSharedMemorySize, LDS_BYTES) != hipSuccess) { fprintf(stderr, "kernel_launch: hipFuncSetAttribute failed\n"); grid = -1; return; }
        if (hipOccupancyMaxActiveBlocksPerMultiprocessor(&per_cu, (const void*)yoco_fwd, NTHREADS, LDS_BYTES) != hipSuccess || per_cu < 1) per_cu = 1;
        (void)hipGetLastError();
        grid = cus * per_cu;
        if (grid != 256) { fprintf(stderr, "kernel_launch: built for a 256-workgroup grid (one per CU), got %d\n", grid); grid = -1; return; }
    }
    if (grid < 0) return;
    if (hipMemsetAsync((char*)d_ws + WS_CTL, 0, CTL_BYTES, stream) != hipSuccess) { fprintf(stderr, "kernel_launch: memset failed\n"); return; }
    Args a{};
    for (int i = 0; i < 19; ++i) a.in[i] = (const float*)d_in[i];
    a.out = (float*)d_out; a.ws = (unsigned char*)d_ws;
    void* args[] = {&a};
    const hipError_t e = hipLaunchCooperativeKernel((const void*)yoco_fwd, dim3(grid), dim3(NTHREADS), args, LDS_BYTES, stream);
    if (e != hipSuccess) fprintf(stderr, "kernel_launch: cooperative launch failed: %s (grid %d)\n", hipGetErrorString(e), grid);
}
```

```cpp
#include <hip/hip_runtime.h>
#include <hip/hip_cooperative_groups.h>
#include <cstdio>
#include <cstdint>
namespace cg = cooperative_groups;
namespace pg8 {
#define PG8_LAS __attribute__((address_space(3)))
typedef unsigned short bf16_t;
typedef short bf16x8 __attribute__((ext_vector_type(8)));
typedef float f32x4 __attribute__((ext_vector_type(4)));
typedef unsigned u32x4 __attribute__((ext_vector_type(4)));
constexpr int BM = 256, BK = 64, HALF = 128, HTB = HALF * BK * 2  , STAGE_BYTES = 8 * HTB, NXCD = 8, WGM = 4;

__host__ __device__ __forceinline__ int lds_byte(int r, int c) { const int st = (r >> 4) * 2 + (c >> 5), rr = r & 15, cc = c & 31, ob = rr * 64 + cc * 2; return st * 1024 + (ob ^ (((ob >> 9) & 1) << 5)); }
__host__ __device__ __forceinline__ void stage_rc(int b, int& R, int& C) { const int st = b / 1024, sb = b % 1024, swz = sb ^ (((sb >> 9) & 1) << 5); R = (st >> 1) * 16 + swz / 64; C = (st & 1) * 32 + (swz % 64) / 2; }
__host__ __device__ __forceinline__ int perm32(int rho) { const int n = rho >> 4, i = rho & 15; return 8 * (i >> 2) + 4 * n + (i & 3); }

struct Unit { int pm, pn, ui; };
struct Gemm { const bf16_t* A; const bf16_t* Bt; int M, N, K; };

struct StaticOrder {
    int nM, nN, nwg, G, c;
    __host__ __device__ void init(int M, int N, int G_, int c_) { nM = M / BM; nN = N / BM; nwg = nM * nN; G = G_; c = c_; }
    __host__ __device__ bool next(int i, Unit& u) const {
        const long L = (long)i * G + c; if (L >= nwg) return false;
        int wgid = (int)L; { const int q = nwg / NXCD, r = nwg % NXCD, xcd = wgid % NXCD, off = wgid / NXCD; wgid = (xcd < r ? xcd * (q + 1) : r * (q + 1) + (xcd - r) * q) + off; }
        const int nig = WGM * nN, gid = wgid / nig, fm = gid * WGM, gsz = (nM - fm) < WGM ? (nM - fm) : WGM;
        u.pm = fm + ((wgid % nig) % gsz); u.pn = (wgid % nig) / gsz; u.ui = i; return true;
    }
    __device__ __forceinline__ void a_ready(const Unit&) const {}
    __device__ __forceinline__ void done(const Unit&) const {}
};
typedef float f32x2_t __attribute__((ext_vector_type(2))); typedef __bf16 bf16x2_t __attribute__((ext_vector_type(2)));
__device__ __forceinline__ unsigned cvt_pk_bf16(float lo, float hi) { f32x2_t v = {lo, hi}; bf16x2_t b = __builtin_convertvector(v, bf16x2_t); return __builtin_bit_cast(unsigned, b); }
typedef float f32x2 __attribute__((ext_vector_type(2)));
typedef unsigned u32x2 __attribute__((ext_vector_type(2)));
constexpr int DMODEL = 1024;
__device__ __forceinline__ float row_rstd(const float* ssqp, int row) {
    const f32x4* p = (const f32x4*)(ssqp + (size_t)row * 16);
    const f32x4 a = p[0], b = p[1], c = p[2], d = p[3];
    const f32x4 s = (a + b) + (c + d);
    const float t = (s[0] + s[1]) + (s[2] + s[3]);
    return __builtin_amdgcn_rsqf(t * (1.0f / 1024.0f) + 1e-5f);
}
constexpr int RSTAB_OFF = 132096;
template <class Sched> __device__ __forceinline__ void fill_rstd(PG8_LAS unsigned char* lds, const float* ssqp, const Sched& S, int tid) {
    PG8_LAS float* tab = (PG8_LAS float*)(lds + RSTAB_OFF); Unit u; const int row = tid >> 1, half = tid & 1;
    for (int i = 0; S.next(i, u); ++i) { const f32x4* p = (const f32x4*)(ssqp + (size_t)(u.pm * BM + row) * 16 + half * 8); const f32x4 a = p[0], b = p[1], s4 = a + b; float s = (s4[0] + s4[1]) + (s4[2] + s4[3]);
        s += __shfl_xor(s, 1); if (half == 0) tab[i * 256 + row] = __builtin_amdgcn_rsqf(s * (1.0f / 1024.0f) + 1e-5f); }
    __syncthreads();
}
__device__ __forceinline__ u32x4 pack8(f32x4 v0, f32x4 v1) { u32x4 w; w.x = cvt_pk_bf16(v0[0], v0[1]); w.y = cvt_pk_bf16(v0[2], v0[3]); w.z = cvt_pk_bf16(v1[0], v1[1]); w.w = cvt_pk_bf16(v1[2], v1[3]); return w; }
__device__ __forceinline__ unsigned short f2bf1(float f) { unsigned u = __builtin_bit_cast(unsigned, f); return (unsigned short)((u + 0x7fffu + ((u >> 16) & 1u)) >> 16); }

struct EpiAIn {
    static constexpr bool PERM = true, AFTER_DRAIN = false;
    bf16_t *V, *BG, *QM; const PG8_LAS float* rstab; float qscale;
    __device__ __forceinline__ void operator()(const f32x4 (&acc)[2][2][4][2], const Unit& u, int wr, int wc, int fr, int fq) const {
        const int row0 = u.pm * BM + wr * 64 + fr, cl = wc * 32 + 8 * fq; const PG8_LAS float* rt = rstab + u.ui * 256 + wr * 64 + fr;
        if (u.pn < 6) {
#pragma unroll
            for (int ai = 0; ai < 2; ++ai)
#pragma unroll
                for (int m = 0; m < 4; ++m) { const int row = row0 + ai * HALF + m * 16; const float r = rt[ai * HALF + m * 16], r2 = r * r;
                    *(u32x4*)(V + (size_t)row * 768 + u.pn * 128 + cl) = pack8(acc[ai][0][m][0] * acc[ai][1][m][0] * r2, acc[ai][0][m][1] * acc[ai][1][m][1] * r2); }
        } else if (u.pn < 9) {
#pragma unroll
            for (int ai = 0; ai < 2; ++ai)
#pragma unroll
                for (int m = 0; m < 4; ++m) { const int row = row0 + ai * HALF + m * 16; const float r = rt[ai * HALF + m * 16];
#pragma unroll
                    for (int bj = 0; bj < 2; ++bj) *(u32x4*)(BG + (size_t)row * 768 + (u.pn - 6) * 256 + bj * HALF + cl) = pack8(acc[ai][bj][m][0] * r, acc[ai][bj][m][1] * r); }
        } else {
#pragma unroll
            for (int ai = 0; ai < 2; ++ai)
#pragma unroll
                for (int m = 0; m < 4; ++m) { const int row = row0 + ai * HALF + m * 16; const float r = rt[ai * HALF + m * 16] * qscale;
#pragma unroll
                    for (int bj = 0; bj < 2; ++bj) *(u32x4*)(QM + (size_t)row * 256 + bj * HALF + cl) = pack8(acc[ai][bj][m][0] * r, acc[ai][bj][m][1] * r); }
        }
    }
};
struct EpiRowScale {
    static constexpr bool PERM = true, AFTER_DRAIN = false;
    bf16_t* O; int ldc; const PG8_LAS float* rstab; float scale; size_t pn_stride; bf16_t* KO; int pn0;
    __device__ __forceinline__ void operator()(const f32x4 (&acc)[2][2][4][2], const Unit& u, int wr, int wc, int fr, int fq) const {
        const int row0 = u.pm * BM + wr * 64 + fr, cl = wc * 32 + 8 * fq; const bool isk = u.pn < pn0;
        bf16_t* ob = isk ? KO + cl : O + (size_t)(u.pn - pn0) * pn_stride + cl; const int ld = isk ? 256 : ldc; const float sc = isk ? 1.0f : scale;
        const PG8_LAS float* rt = rstab + u.ui * 256 + wr * 64 + fr;
#pragma unroll
        for (int ai = 0; ai < 2; ++ai)
#pragma unroll
            for (int m = 0; m < 4; ++m) { const int row = row0 + ai * HALF + m * 16; const float r = rstab ? rt[ai * HALF + m * 16] * sc : sc;
#pragma unroll
                for (int bj = 0; bj < 2; ++bj) *(u32x4*)(ob + (size_t)row * ld + bj * HALF) = pack8(acc[ai][bj][m][0] * r, acc[ai][bj][m][1] * r); }
    }
};
struct EpiVT {
    static constexpr bool PERM = true, AFTER_DRAIN = true;
    bf16_t* O; int ld; const float* ssqp; size_t pm_stride, pn_stride;
    __device__ __forceinline__ void fused(f32x4 (&acc)[2][2][4][2], const Unit& u, int wr, int wc, int fr, int fq, PG8_LAS unsigned char* lds, int wid, int lane) const {
        PG8_LAS float* rs = (PG8_LAS float*)lds;
        { const int t = wid * 64 + lane, tok = t >> 1, half = t & 1; float r = 1.0f;
          if (ssqp) { const f32x4* p = (const f32x4*)(ssqp + (size_t)(u.pn * BM + tok) * 16 + half * 8); const f32x4 a = p[0], b = p[1], s4 = a + b; float s = (s4[0] + s4[1]) + (s4[2] + s4[3]);
              s += __shfl_xor(s, 1); r = __builtin_amdgcn_rsqf(s * (1.0f / 1024.0f) + 1e-5f); }
          if (half == 0) rs[tok] = r; }
        asm volatile("s_waitcnt lgkmcnt(0)" ::: "memory"); __builtin_amdgcn_s_barrier(); asm volatile("" ::: "memory");
        const int rl0 = wr * 64 + fr, cl = wc * 32 + 8 * fq; bf16_t* ob = O + (size_t)u.pm * pm_stride + (size_t)u.pn * pn_stride + cl;
#pragma unroll
        for (int bj = 0; bj < 2; ++bj) {
            const f32x4 s0 = *(const PG8_LAS f32x4*)(rs + bj * HALF + cl), s1 = *(const PG8_LAS f32x4*)(rs + bj * HALF + cl + 4);
#pragma unroll
            for (int ai = 0; ai < 2; ++ai)
#pragma unroll
                for (int m = 0; m < 4; ++m) *(u32x4*)(ob + (size_t)(rl0 + ai * HALF + m * 16) * ld + bj * HALF) = pack8(acc[ai][bj][m][0] * s0, acc[ai][bj][m][1] * s1);
        }
        asm volatile("s_waitcnt lgkmcnt(0)" ::: "memory"); __builtin_amdgcn_s_barrier(); asm volatile("" ::: "memory");
    }
};
struct EpiSwiglu {
    static constexpr bool PERM = true, AFTER_DRAIN = false;
    bf16_t* H; const PG8_LAS float* rstab;
    __device__ __forceinline__ void operator()(const f32x4 (&acc)[2][2][4][2], const Unit& u, int wr, int wc, int fr, int fq) const {
        const int row0 = u.pm * BM + wr * 64 + fr, cl = u.pn * 128 + wc * 32 + 8 * fq; const PG8_LAS float* rt = rstab + u.ui * 256 + wr * 64 + fr;
#pragma unroll
        for (int ai = 0; ai < 2; ++ai)
#pragma unroll
            for (int m = 0; m < 4; ++m) { const int row = row0 + ai * HALF + m * 16; const float r = rt[ai * HALF + m * 16], nr = r * -1.4426950408889634f, r2 = r * r;
                f32x4 hv[2];
#pragma unroll
                for (int n = 0; n < 2; ++n) { const f32x4 ag = acc[ai][0][m][n], au = acc[ai][1][m][n]; const f32x4 t = ag * nr, gu = (ag * au) * r2; f32x4 d;
#pragma unroll
                    for (int j = 0; j < 4; ++j) d[j] = __builtin_amdgcn_rcpf(1.0f + __builtin_amdgcn_exp2f(t[j]));
                    hv[n] = gu * d; }
                __builtin_nontemporal_store(pack8(hv[0], hv[1]), (u32x4*)(H + (size_t)row * 2816 + cl)); }
    }
};
struct EpiRes {
    static constexpr bool PERM = true, AFTER_DRAIN = false;
    bf16_t* xb; float* ssqp;
    __device__ __forceinline__ void operator()(const f32x4 (&acc)[2][2][4][2], const Unit& u, int wr, int wc, int fr, int fq) const {
        const int row0 = u.pm * BM + wr * 64 + fr, cl = u.pn * BM + wc * 32 + 8 * fq;
#pragma unroll
        for (int ai = 0; ai < 2; ++ai)
#pragma unroll
            for (int m = 0; m < 4; ++m) { const int row = row0 + ai * HALF + m * 16; bf16_t* xp = xb + (size_t)row * DMODEL + cl; float q = 0.f;
#pragma unroll
                for (int bj = 0; bj < 2; ++bj) { const u32x4 o = *(const u32x4*)(xp + bj * HALF);
                    const f32x4 b0 = {__builtin_bit_cast(float, o.x << 16), __builtin_bit_cast(float, o.x & 0xffff0000u), __builtin_bit_cast(float, o.y << 16), __builtin_bit_cast(float, o.y & 0xffff0000u)};
                    const f32x4 b1 = {__builtin_bit_cast(float, o.z << 16), __builtin_bit_cast(float, o.z & 0xffff0000u), __builtin_bit_cast(float, o.w << 16), __builtin_bit_cast(float, o.w & 0xffff0000u)};
                    const f32x4 x0 = b0 + acc[ai][bj][m][0], x1 = b1 + acc[ai][bj][m][1];
                    *(u32x4*)(xp + bj * HALF) = pack8(x0, x1);
                    q += (x0[0] * x0[0] + x0[1] * x0[1]) + (x0[2] * x0[2] + x0[3] * x0[3]) + (x1[0] * x1[0] + x1[1] * x1[1]) + (x1[2] * x1[2] + x1[3] * x1[3]); }
                q += __shfl_xor(q, 16); q += __shfl_xor(q, 32);
                if (fq == 0) ssqp[(size_t)row * 16 + u.pn * 4 + wc] = q; }
    }
};
template <class Epi, class Sched, bool ALIGN_EPI = false, bool SP2 = false>
__device__ __forceinline__ void gemm_phase(PG8_LAS unsigned char* lds, const Gemm g, const Sched& S, const Epi& E, const int tid) {
    const int wid = __builtin_amdgcn_readfirstlane(tid >> 6), lane = tid & 63, wr = wid >> 2, wc = wid & 3, fr = lane & 15, fq = lane >> 4;
    const int K = g.K, nt = K / BK;
    unsigned voffA[2], voffB[2];
#pragma unroll
    for (int i = 0; i < 2; ++i) { int R, C; stage_rc(tid * 16 + i * 8192, R, C); const int Rb = Epi::PERM ? ((R & ~31) + perm32(R & 31)) : R;
        voffA[i] = (unsigned)(R * K + C) * 2u; voffB[i] = (unsigned)(Rb * K + C) * 2u; }
    const size_t kstep = (size_t)(BK * 2);
    const size_t hstep = (size_t)HALF * K * 2;
    const size_t tstep = 2 * hstep;
    const unsigned ldsw = (unsigned)wid * 1024u;
    const int aoff = lds_byte(wr * 64 + fr, fq * 8), boff = lds_byte(wc * 32 + fr, fq * 8);
#define PG8_SA(b, h) (((b) * 2 + (h)) * HTB)
#define PG8_SB(b, h) ((4 + (b) * 2 + (h)) * HTB)
#define PG8_STAGE(bufoff, gbase, voff) do { _Pragma("unroll") for (int _i = 0; _i < 2; ++_i) \
        __builtin_amdgcn_global_load_lds((const unsigned*)((const char*)(gbase) + (voff)[_i]), (PG8_LAS unsigned*)(lds + (bufoff) + ldsw + _i * 8192), 16, 0, 0); } while (0)
#define PG8_LDA(dst, b, h) do { _Pragma("unroll") for (int m = 0; m < 4; ++m) _Pragma("unroll") for (int k = 0; k < 2; ++k) dst[m][k] = *(const PG8_LAS bf16x8*)(lds + PG8_SA(b, h) + aoff + m * 2048 + k * 1024); } while (0)
#define PG8_LDB(dst, b, h) do { _Pragma("unroll") for (int n = 0; n < 2; ++n) _Pragma("unroll") for (int k = 0; k < 2; ++k) dst[n][k] = *(const PG8_LAS bf16x8*)(lds + PG8_SB(b, h) + boff + n * 2048 + k * 1024); } while (0)
#define PG8_MMA(ai, bj, At, Bt) do { __builtin_amdgcn_s_setprio(1); _Pragma("unroll") for (int m = 0; m < 4; ++m) _Pragma("unroll") for (int n = 0; n < 2; ++n) _Pragma("unroll") for (int k = 0; k < 2; ++k) \
        acc[ai][bj][m][n] = __builtin_amdgcn_mfma_f32_16x16x32_bf16(Bt[n][k], At[m][k], acc[ai][bj][m][n], 0, 0, 0); __builtin_amdgcn_s_setprio(0); } while (0)
#define PG8_WAIT_V(n) asm volatile("s_waitcnt vmcnt(" #n ")" ::: "memory")
#define PG8_WAIT_L(n) asm volatile("s_waitcnt lgkmcnt(" #n ")" ::: "memory")
#define PG8_BAR __builtin_amdgcn_s_barrier()
#define PG8_SCHED __builtin_amdgcn_sched_barrier(0)
    Unit cur, nxt; int ui = 0;
    if (!S.next(0, cur)) return;
    f32x4 acc[2][2][4][2];
#pragma unroll
    for (int a = 0; a < 2; ++a)
#pragma unroll
        for (int b = 0; b < 2; ++b)
#pragma unroll
            for (int m = 0; m < 4; ++m)
#pragma unroll
                for (int n = 0; n < 2; ++n) acc[a][b][m][n] = (f32x4){0.f, 0.f, 0.f, 0.f};
    bf16x8 At[4][2], B0[2][2], B1[2][2];
    const char* cA = (const char*)g.A + (size_t)cur.pm * tstep; const char* cB = (const char*)g.Bt + (size_t)cur.pn * tstep;
    S.a_ready(cur);
    if constexpr (SP2) {
        PG8_STAGE(PG8_SB(0, 0), cB, voffB); PG8_STAGE(PG8_SB(0, 1), cB + hstep, voffB); PG8_STAGE(PG8_SA(0, 0), cA, voffA); PG8_STAGE(PG8_SA(0, 1), cA + hstep, voffA);
        if (wr == 1) PG8_BAR;
        PG8_WAIT_V(2); PG8_BAR;
        PG8_STAGE(PG8_SB(1, 0), cB + kstep, voffB); PG8_STAGE(PG8_SA(1, 0), cA + kstep, voffA); PG8_STAGE(PG8_SB(1, 1), cB + hstep + kstep, voffB);
        PG8_WAIT_V(6); PG8_BAR;
    } else {
        PG8_STAGE(PG8_SB(0, 0), cB, voffB); PG8_STAGE(PG8_SA(0, 0), cA, voffA); PG8_STAGE(PG8_SB(0, 1), cB + hstep, voffB); PG8_STAGE(PG8_SA(0, 1), cA + hstep, voffA);
        if (wr == 1) PG8_BAR;
        PG8_WAIT_V(4); PG8_BAR;
        PG8_STAGE(PG8_SB(1, 0), cB + kstep, voffB); PG8_STAGE(PG8_SA(1, 0), cA + kstep, voffA); PG8_STAGE(PG8_SB(1, 1), cB + hstep + kstep, voffB);
        PG8_WAIT_V(6); PG8_BAR;
    }
    for (;;) {
        const bool has_next = S.next(ui + 1, nxt);
        const char* nA = has_next ? (const char*)g.A + (size_t)nxt.pm * tstep : cA; const char* nB = has_next ? (const char*)g.Bt + (size_t)nxt.pn * tstep : cB;
        for (int t = 0; t < nt; t += 2) {
            const bool last = (t == nt - 2);
            const char* a1 = cA + (size_t)(t + 1) * kstep;
            const char* a2 = last ? nA : cA + (size_t)(t + 2) * kstep; const char* b2 = last ? nB : cB + (size_t)(t + 2) * kstep;
            const char* a3 = a2 + kstep; const char* b3 = b2 + kstep;
            if (last && has_next) S.a_ready(nxt);
            if constexpr (SP2) {
            PG8_LDB(B0, 0, 0); PG8_LDB(B1, 0, 1); PG8_SCHED; PG8_LDA(At, 0, 0); PG8_STAGE(PG8_SA(1, 1), a1 + hstep, voffA);
            PG8_WAIT_V(8); PG8_WAIT_L(0); PG8_BAR; PG8_MMA(0, 0, At, B0); PG8_MMA(0, 1, At, B1); PG8_BAR; PG8_SCHED;
            PG8_LDA(At, 0, 1); PG8_STAGE(PG8_SB(0, 0), b2, voffB); PG8_STAGE(PG8_SB(0, 1), b2 + hstep, voffB); PG8_STAGE(PG8_SA(0, 0), a2, voffA);
            PG8_WAIT_V(8); PG8_WAIT_L(0); PG8_BAR; PG8_MMA(1, 0, At, B0); PG8_MMA(1, 1, At, B1); PG8_BAR; PG8_SCHED;
            PG8_LDB(B0, 1, 0); PG8_LDB(B1, 1, 1); PG8_SCHED; PG8_LDA(At, 1, 0); PG8_STAGE(PG8_SA(0, 1), a2 + hstep, voffA);
            PG8_WAIT_V(8); PG8_WAIT_L(0); PG8_BAR; PG8_MMA(0, 0, At, B0); PG8_MMA(0, 1, At, B1); PG8_BAR; PG8_SCHED;
            PG8_LDA(At, 1, 1); PG8_STAGE(PG8_SB(1, 0), b3, voffB); PG8_STAGE(PG8_SB(1, 1), b3 + hstep, voffB); PG8_STAGE(PG8_SA(1, 0), a3, voffA);
            PG8_WAIT_V(8); PG8_WAIT_L(0); PG8_BAR; PG8_MMA(1, 0, At, B0); PG8_MMA(1, 1, At, B1); PG8_BAR; PG8_SCHED;
            } else {
            PG8_LDB(B0, 0, 0); PG8_SCHED; PG8_LDA(At, 0, 0); PG8_STAGE(PG8_SA(1, 1), a1 + hstep, voffA);
            PG8_WAIT_L(8); PG8_BAR; PG8_WAIT_L(0); PG8_MMA(0, 0, At, B0); PG8_BAR; PG8_SCHED;
            PG8_LDB(B1, 0, 1); PG8_STAGE(PG8_SB(0, 0), b2, voffB);
            PG8_BAR; PG8_WAIT_L(0); PG8_MMA(0, 1, At, B1); PG8_BAR;
            PG8_LDA(At, 0, 1); PG8_STAGE(PG8_SA(0, 0), a2, voffA);
            PG8_BAR; PG8_WAIT_L(0); PG8_MMA(1, 0, At, B0); PG8_BAR; PG8_SCHED;
            PG8_STAGE(PG8_SB(0, 1), b2 + hstep, voffB);
            PG8_WAIT_V(6); PG8_BAR; PG8_MMA(1, 1, At, B1); PG8_BAR;
            PG8_LDB(B0, 1, 0); PG8_SCHED; PG8_LDA(At, 1, 0); PG8_STAGE(PG8_SA(0, 1), a2 + hstep, voffA);
            PG8_WAIT_L(8); PG8_BAR; PG8_WAIT_L(0); PG8_MMA(0, 0, At, B0); PG8_BAR; PG8_SCHED;
            PG8_LDB(B1, 1, 1); PG8_STAGE(PG8_SB(1, 0), b3, voffB);
            PG8_BAR; PG8_WAIT_L(0); PG8_MMA(0, 1, At, B1); PG8_BAR;
            PG8_LDA(At, 1, 1); PG8_STAGE(PG8_SA(1, 0), a3, voffA);
            PG8_BAR; PG8_WAIT_L(0); PG8_MMA(1, 0, At, B0); PG8_BAR; PG8_SCHED;
            PG8_STAGE(PG8_SB(1, 1), b3 + hstep, voffB);
            PG8_WAIT_V(6); PG8_BAR; PG8_MMA(1, 1, At, B1); PG8_BAR;
            }
        }
        if constexpr (ALIGN_EPI) { if (wr == 0) PG8_BAR; }
        if constexpr (!Epi::AFTER_DRAIN) { E(acc, cur, wr, wc, fr, fq); S.done(cur); }
        if (!has_next) break;
#pragma unroll
        for (int a = 0; a < 2; ++a)
#pragma unroll
            for (int b = 0; b < 2; ++b)
#pragma unroll
                for (int m = 0; m < 4; ++m)
#pragma unroll
                    for (int n = 0; n < 2; ++n) acc[a][b][m][n] = (f32x4){0.f, 0.f, 0.f, 0.f};
        cur = nxt; cA = nA; cB = nB; ++ui;
        if constexpr (ALIGN_EPI) { if (wr == 1) PG8_BAR; }
    }
    PG8_WAIT_V(0);
    if constexpr (!ALIGN_EPI) { if (wr == 0) PG8_BAR; }
    PG8_BAR;
    if constexpr (Epi::AFTER_DRAIN) { E.fused(acc, cur, wr, wc, fr, fq, lds, wid, lane); S.done(cur); }
#undef PG8_SA
#undef PG8_SB
#undef PG8_STAGE
#undef PG8_LDA
#undef PG8_LDB
#undef PG8_MMA
#undef PG8_WAIT_V
#undef PG8_WAIT_L
#undef PG8_BAR
#undef PG8_SCHED
}
}

constexpr int BATCH = 2, SEQ = 16384, D = 1024, M = BATCH * SEQ, NMEM = 256, DFF = 2816, CONVW = 768, APROJ = 2560;
constexpr int NWAVES = 8, NTHREADS = 512;
constexpr float LOG2E = 1.4426950408889634f, QSCALE = 0.125f * LOG2E, EPS = 1e-5f;

constexpr size_t MiB = 1u << 20;
constexpr size_t WS_SSQ = 0;
constexpr size_t WS_MEMN = 2 * MiB;
constexpr size_t WS_MK = 3 * MiB;
constexpr size_t WS_MVT = 4 * MiB;
constexpr size_t WS_WAIN = 5 * MiB;
constexpr size_t WS_WAOUT = 15 * MiB;
constexpr size_t WS_WKV = 19 * MiB;
constexpr size_t WS_WBQ = 20 * MiB;
constexpr size_t WS_WBOUT = 24 * MiB;
constexpr size_t WS_WMEMKV = 28 * MiB;
constexpr size_t WS_WUP = 32 * MiB;
constexpr size_t WS_WDOWN = 76 * MiB;
constexpr size_t WS_XB = 98 * MiB;
constexpr size_t WS_KB = 162 * MiB;
constexpr size_t WS_VT = 178 * MiB;
constexpr size_t WS_H = 194 * MiB;
constexpr size_t WS_V = WS_H;
constexpr size_t WS_BG = WS_H + 48 * MiB;
constexpr size_t WS_QM = WS_H + 96 * MiB;
constexpr size_t WS_Y = WS_H + 112 * MiB;
constexpr size_t WS_Q = WS_H;
constexpr size_t WS_CTL = 370 * MiB, CTL_BYTES = 65536;
constexpr size_t WS_END = 371 * MiB;

constexpr int LDS_BYTES = 147456;
#define LAS __attribute__((address_space(3)))
typedef unsigned short bf16;
typedef unsigned v4u __attribute__((ext_vector_type(4)));
typedef unsigned v2u __attribute__((ext_vector_type(2)));
typedef float f32x4 __attribute__((ext_vector_type(4)));
typedef float f32x16 __attribute__((ext_vector_type(16)));
typedef short bf16x8 __attribute__((ext_vector_type(8)));
typedef short s16x4 __attribute__((ext_vector_type(4)));
#define LDS_WAIT() asm volatile("s_waitcnt lgkmcnt(0)" ::: "memory")
__device__ __forceinline__ unsigned f2bf(float f) { unsigned u = __builtin_bit_cast(unsigned, f); return (u + 0x7fffu + ((u >> 16) & 1u)) >> 16; }
__device__ __forceinline__ unsigned pk2(float lo, float hi) { return pg8::cvt_pk_bf16(lo, hi); }
__device__ __forceinline__ float bflo(unsigned u) { return __builtin_bit_cast(float, u << 16); }
__device__ __forceinline__ float bfhi(unsigned u) { return __builtin_bit_cast(float, u & 0xffff0000u); }
__device__ __forceinline__ float wave_sum(float v) {
#pragma unroll
    for (int o = 1; o < 64; o <<= 1) v += __shfl_xor(v, o);
    return v;
}

struct Args { const float* in[19]; float* out; unsigned char* ws; };
typedef const Args __attribute__((address_space(4)))* CArgsP;
__device__ __forceinline__ CArgsP kargs() { CArgsP p = (CArgsP)__builtin_amdgcn_kernarg_segment_ptr(); asm volatile("" : "+s"(p)); return p; }
enum { I_X = 0, I_MEM, I_NORM_MIX, I_NORM_FFN, I_A_W_IN, I_A_CONV_W, I_A_W_OUT, I_KV_NORM, I_W_KV, I_B_W_Q, I_B_SINKS, I_B_W_OUT, I_REL_BIAS, I_MEM_NORM, I_W_MEM_KV, I_W_GATE, I_W_UP, I_W_DOWN, I_FINAL_NORM };

template <bool HAS_GAIN>
__device__ __forceinline__ void transpose_item(const float* W, int K, int Nsrc, const float* gain, bf16* WT, int dst_row0, int k0, int n0, LAS float* scr, int lane) {
    const int c = lane & 7;
    f32x4 g0 = {1.f, 1.f, 1.f, 1.f}, g1 = {1.f, 1.f, 1.f, 1.f};
    if (HAS_GAIN) { g0 = *(const f32x4*)(gain + k0 + 8 * c); g1 = *(const f32x4*)(gain + k0 + 8 * c + 4); }
#pragma unroll
    for (int i = 0; i < 32; ++i) { const int kk = 2 * i + (lane >> 5); scr[kk * 33 + (lane & 31)] = W[(size_t)(k0 + kk) * Nsrc + n0 + (lane & 31)]; }
    LDS_WAIT(); asm volatile("" ::: "memory");
#pragma unroll
    for (int j = 0; j < 4; ++j) { const int n = (lane >> 3) + 8 * j; const LAS float* s = scr + (8 * c) * 33 + n;
        v4u o; o.x = pk2(s[0 * 33] * g0[0], s[1 * 33] * g0[1]); o.y = pk2(s[2 * 33] * g0[2], s[3 * 33] * g0[3]); o.z = pk2(s[4 * 33] * g1[0], s[5 * 33] * g1[1]); o.w = pk2(s[6 * 33] * g1[2], s[7 * 33] * g1[3]);
        __builtin_nontemporal_store(o, (v4u*)(WT + (size_t)(dst_row0 + n) * K + k0 + 8 * c)); }
    LDS_WAIT(); asm volatile("" ::: "memory");
}
__device__ __forceinline__ void prologue(LAS unsigned char* lds, int gw, int NGW, int wave, int lane) {
    const CArgsP ka = kargs(); unsigned char* ws = ka->ws;
    LAS float* scr = (LAS float*)(lds + wave * 16384);
    constexpr int N_AIN = 16 * 80, N_SQ = 16 * 32, N_KV = 16 * 16, N_FF = 16 * 88, N_DN = 44 * 32;
    constexpr int NITEMS = 2 * N_AIN + 2 * N_SQ + N_KV + 2 * N_SQ + 2 * N_SQ + 4 * N_KV + 4 * N_FF + 4 * N_FF + 4 * N_DN;
    for (int it = gw; it < NITEMS; it += NGW) {
        int r = it;
        if (r < 2 * N_AIN) { const int l = r / N_AIN; r %= N_AIN; const int kb = r / 80, nb = r % 80, n0 = 32 * nb;
            int dst; if (n0 < 768) dst = 256 * (n0 / 128) + (n0 % 128); else if (n0 < 1536) dst = 1536 + (n0 - 768); else if (n0 < 2304) dst = 256 * ((n0 - 1536) / 128) + 128 + ((n0 - 1536) % 128); else dst = n0;
            transpose_item<true>(ka->in[I_A_W_IN] + (size_t)l * D * APROJ, D, APROJ, ka->in[I_NORM_MIX] + l * D, (bf16*)(ws + WS_WAIN) + (size_t)l * APROJ * D, dst, 64 * kb, n0, scr, lane); continue; }
        r -= 2 * N_AIN;
        if (r < 2 * N_SQ) { const int l = r / N_SQ; r %= N_SQ; const int kb = r / 32, nb = r % 32;
            transpose_item<false>(ka->in[I_A_W_OUT] + (size_t)l * D * D, D, D, nullptr, (bf16*)(ws + WS_WAOUT) + (size_t)l * D * D, 32 * nb, 64 * kb, 32 * nb, scr, lane); continue; }
        r -= 2 * N_SQ;
        if (r < N_KV) { const int kb = r / 16, nb = r % 16;
            transpose_item<true>(ka->in[I_W_KV], D, 512, ka->in[I_KV_NORM], (bf16*)(ws + WS_WKV), (nb < 8 ? 256 + 32 * nb : 32 * (nb - 8)), 64 * kb, 32 * nb, scr, lane); continue; }
        r -= N_KV;
        if (r < 2 * N_SQ) { const int l = r / N_SQ; r %= N_SQ; const int kb = r / 32, nb = r % 32;
            transpose_item<true>(ka->in[I_B_W_Q] + (size_t)l * D * D, D, D, ka->in[I_NORM_MIX] + (2 + l) * D, (bf16*)(ws + WS_WBQ) + (size_t)l * D * D, 32 * nb, 64 * kb, 32 * nb, scr, lane); continue; }
        r -= 2 * N_SQ;
        if (r < 2 * N_SQ) { const int l = r / N_SQ; r %= N_SQ; const int kb = r / 32, nb = r % 32;
            transpose_item<false>(ka->in[I_B_W_OUT] + (size_t)l * D * D, D, D, nullptr, (bf16*)(ws + WS_WBOUT) + (size_t)l * D * D, 32 * nb, 64 * kb, 32 * nb, scr, lane); continue; }
        r -= 2 * N_SQ;
        if (r < 4 * N_KV) { const int l = r / N_KV; r %= N_KV; const int kb = r / 16, nb = r % 16;
            transpose_item<false>(ka->in[I_W_MEM_KV] + (size_t)l * D * 512, D, 512, nullptr, (bf16*)(ws + WS_WMEMKV), (nb < 8 ? 256 * l + 32 * nb : 1024 + 256 * l + 32 * (nb - 8)), 64 * kb, 32 * nb, scr, lane); continue; }
        r -= 4 * N_KV;
        if (r < 8 * N_FF) { const int which = r / (4 * N_FF); r %= 4 * N_FF; const int l = r / N_FF; r %= N_FF; const int kb = r / 88, nb = r % 88, n0 = 32 * nb;
            const int dst = 256 * (n0 / 128) + 128 * which + (n0 % 128);
            transpose_item<true>((which ? ka->in[I_W_UP] : ka->in[I_W_GATE]) + (size_t)l * D * DFF, D, DFF, ka->in[I_NORM_FFN] + l * D, (bf16*)(ws + WS_WUP) + (size_t)l * 2 * DFF * D, dst, 64 * kb, n0, scr, lane); continue; }
        r -= 8 * N_FF;
        { const int l = r / N_DN; r %= N_DN; const int kb = r / 32, nb = r % 32;
            transpose_item<false>(ka->in[I_W_DOWN] + (size_t)l * DFF * D, DFF, D, nullptr, (bf16*)(ws + WS_WDOWN) + (size_t)l * D * DFF, 32 * nb, 64 * kb, 32 * nb, scr, lane); }
    }
    const float* x = ka->in[I_X]; bf16* XB = (bf16*)(ws + WS_XB); float* ssqp = (float*)(ws + WS_SSQ);
    for (int m0 = gw; m0 < M; m0 += 4 * NGW) {
        f32x4 v[4][4];
#pragma unroll
        for (int q = 0; q < 4; ++q) { const f32x4* xr = (const f32x4*)(x + (size_t)(m0 + q * NGW) * D) + lane;
#pragma unroll
            for (int j = 0; j < 4; ++j) v[q][j] = xr[64 * j]; }
#pragma unroll
        for (int q = 0; q < 4; ++q) { const int m = m0 + q * NGW; float s = 0.f;
#pragma unroll
            for (int j = 0; j < 4; ++j) s += (v[q][j].x * v[q][j].x + v[q][j].y * v[q][j].y) + (v[q][j].z * v[q][j].z + v[q][j].w * v[q][j].w);
            s = wave_sum(s);
            unsigned long long* o8 = (unsigned long long*)(XB + (size_t)m * D) + lane;
#pragma unroll
            for (int j = 0; j < 4; ++j) o8[64 * j] = (unsigned long long)pk2(v[q][j].x, v[q][j].y) | ((unsigned long long)pk2(v[q][j].z, v[q][j].w) << 32);
            if (lane < 16) ssqp[(size_t)m * 16 + lane] = lane == 0 ? s : 0.f; }
    }
    const float* mem = ka->in[I_MEM]; const float* mg = ka->in[I_MEM_NORM]; bf16* MEMN = (bf16*)(ws + WS_MEMN);
    for (int m = gw; m < BATCH * NMEM; m += NGW) {
        const f32x4* xr = (const f32x4*)(mem + (size_t)m * D) + lane; const f32x4* gr = (const f32x4*)mg + lane; f32x4 v[4]; float s = 0.f;
#pragma unroll
        for (int j = 0; j < 4; ++j) { v[j] = xr[64 * j]; s += (v[j].x * v[j].x + v[j].y * v[j].y) + (v[j].z * v[j].z + v[j].w * v[j].w); }
        const float rstd = 1.0f / sqrtf(wave_sum(s) * (1.0f / D) + EPS);
        unsigned long long* o8 = (unsigned long long*)(MEMN + (size_t)m * D) + lane;
#pragma unroll
        for (int j = 0; j < 4; ++j) { const f32x4 g = gr[64 * j]; const f32x4 y = v[j] * rstd * g; o8[64 * j] = (unsigned long long)pk2(y.x, y.y) | ((unsigned long long)pk2(y.z, y.w) << 32); }
    }
}

__device__ __forceinline__ unsigned cvtpk(float lo, float hi) { return pg8::cvt_pk_bf16(lo, hi); }
__device__ __forceinline__ void softmax_block(f32x16& S, float& m, float& l, f32x16& o0, f32x16& o1, bf16x8& p0, bf16x8& p1) {
    float bm = fmaxf(S[0], S[1]);
#pragma unroll
    for (int i = 2; i < 16; ++i) bm = fmaxf(bm, S[i]);
    bm = fmaxf(bm, __shfl_xor(bm, 32));
    const float mn = fmaxf(m, bm);
    const float alpha = __builtin_amdgcn_exp2f(m - mn);
    m = mn;
    float sum = 0.f;
#pragma unroll
    for (int i = 0; i < 16; ++i) { S[i] = __builtin_amdgcn_exp2f(S[i] - mn); sum += S[i]; }
    l = l * alpha + sum;
#pragma unroll
    for (int i = 0; i < 16; ++i) { o0[i] *= alpha; o1[i] *= alpha; }
    v4u w0, w1;
    w0.x = cvtpk(S[0], S[1]); w0.y = cvtpk(S[2], S[3]); w0.z = cvtpk(S[4], S[5]); w0.w = cvtpk(S[6], S[7]);
    w1.x = cvtpk(S[8], S[9]); w1.y = cvtpk(S[10], S[11]); w1.z = cvtpk(S[12], S[13]); w1.w = cvtpk(S[14], S[15]);
    p0 = __builtin_bit_cast(bf16x8, w0); p1 = __builtin_bit_cast(bf16x8, w1);
}
__device__ __forceinline__ void attn_store(const f32x16& o0, const f32x16& o1, float l, bf16* yrow, int hi) {
    l += __shfl_xor(l, 32);
    const float inv = 1.0f / l;
#pragma unroll
    for (int g = 0; g < 4; ++g) {
        v2u w; w.x = pk2(o0[4 * g] * inv, o0[4 * g + 1] * inv); w.y = pk2(o0[4 * g + 2] * inv, o0[4 * g + 3] * inv); *(v2u*)(yrow + 8 * g + 4 * hi) = w;
        v2u z; z.x = pk2(o1[4 * g] * inv, o1[4 * g + 1] * inv); z.y = pk2(o1[4 * g + 2] * inv, o1[4 * g + 3] * inv); *(v2u*)(yrow + 32 + 8 * g + 4 * hi) = z;
    }
}
constexpr int KIMG_STRIDE = 144, VIMG_STRIDE = 528, KIMG_BYTES = 256 * KIMG_STRIDE, VIMG_BYTES = 64 * VIMG_STRIDE, TAB_OFF = KIMG_BYTES + VIMG_BYTES;
__device__ __forceinline__ void mem_stage(LAS unsigned char* lds, const bf16* MK, const bf16* MVT, int layer, int b, int h, int tid) {
    const bf16* ksrc = MK + ((size_t)layer * 512 + b * 256) * 256 + h * 64;
    for (int i = tid; i < 256 * 8; i += NTHREADS) { const int key = i >> 3, c = i & 7; *(LAS v4u*)(lds + key * KIMG_STRIDE + c * 16) = *(const v4u*)(ksrc + (size_t)key * 256 + c * 8); }
    const bf16* vsrc = MVT + ((size_t)(layer * 2 + b) * 256 + h * 64) * 256;
    for (int i = tid; i < 64 * 32; i += NTHREADS) { const int d = i >> 5, c = i & 31; *(LAS v4u*)(lds + KIMG_BYTES + d * VIMG_STRIDE + c * 16) = *(const v4u*)(vsrc + (size_t)d * 256 + c * 8); }
    __syncthreads();
}
__device__ __forceinline__ void mem_attn_unit(LAS unsigned char* lds, const bf16* q, int ldq, bf16* y, int ldy, int lane) {
    const int r = lane & 31, hi = lane >> 5;
    bf16x8 qf[4];
#pragma unroll
    for (int s = 0; s < 4; ++s) qf[s] = *(const bf16x8*)(q + (size_t)r * ldq + 16 * s + 8 * hi);
    float m = -1e30f, l = 0.f; f32x16 o0 = {}, o1 = {};
    for (int kb = 0; kb < 8; ++kb) {
        f32x16 S = {};
#pragma unroll
        for (int s = 0; s < 4; ++s) { const bf16x8 kf = *(const LAS bf16x8*)(lds + (kb * 32 + r) * KIMG_STRIDE + (16 * s + 8 * hi) * 2); S = __builtin_amdgcn_mfma_f32_32x32x16_bf16(kf, qf[s], S, 0, 0, 0); }
        bf16x8 p0, p1; softmax_block(S, m, l, o0, o1, p0, p1);
#pragma unroll
        for (int s = 0; s < 2; ++s) {
            const bf16x8 pb = s ? p1 : p0;
#pragma unroll
            for (int db = 0; db < 2; ++db) {
                const LAS unsigned char* vp = lds + KIMG_BYTES + (db * 32 + r) * VIMG_STRIDE + (kb * 32 + 16 * s + 4 * hi) * 2;
                const s16x4 a = *(const LAS s16x4*)vp, c = *(const LAS s16x4*)(vp + 16);
                const bf16x8 vf = (bf16x8){a[0], a[1], a[2], a[3], c[0], c[1], c[2], c[3]};
                if (db == 0) o0 = __builtin_amdgcn_mfma_f32_32x32x16_bf16(vf, pb, o0, 0, 0, 0); else o1 = __builtin_amdgcn_mfma_f32_32x32x16_bf16(vf, pb, o1, 0, 0, 0);
            }
        }
    }
    attn_store(o0, o1, l, y + (size_t)r * ldy, hi);
}
__device__ __forceinline__ void mem_attn_phase(LAS unsigned char* lds, const bf16* MK, const bf16* MVT, int layer, const bf16* Q, int ldq, int qcol0, bf16* Y, int tid, int wave, int lane) {
    const int G = gridDim.x, bh = blockIdx.x & 7, b = bh >> 2, h = bh & 3, slot = blockIdx.x >> 3, nslots = (G - bh + 7) >> 3;
    mem_stage(lds, MK, MVT, layer, b, h, tid);
    for (int g = slot * NWAVES + wave; g < SEQ / 32; g += nslots * NWAVES) {
        const size_t row0 = (size_t)b * SEQ + (size_t)g * 32;
        mem_attn_unit(lds, Q + row0 * ldq + qcol0 + h * 64, ldq, Y + row0 * D + CONVW + h * 64, D, lane);
    }
    __syncthreads();
}

__device__ __forceinline__ void conv_phase(const bf16* V, const bf16* BG, const float* cw, bf16* Y, int gtid, int nthreads) {
    constexpr int NCH = CONVW / 8;
    for (int idx = gtid; idx < (M / 4) * NCH; idx += nthreads) {
        const int rg = idx / NCH, ch = idx % NCH, c0 = ch * 8, t0 = rg * 4, tl = t0 % SEQ;
        float w0[8], w1[8], w2[8];
#pragma unroll
        for (int j = 0; j < 8; j += 4) { const f32x4 a = *(const f32x4*)(cw + c0 + j), b = *(const f32x4*)(cw + CONVW + c0 + j), c = *(const f32x4*)(cw + 2 * CONVW + c0 + j);
#pragma unroll
            for (int e = 0; e < 4; ++e) { w0[j + e] = a[e]; w1[j + e] = b[e]; w2[j + e] = c[e]; } }
        float vm2[8], vm1[8];
        if (tl != 0) { const v4u a = *(const v4u*)(V + (size_t)(t0 - 2) * CONVW + c0), b = *(const v4u*)(V + (size_t)(t0 - 1) * CONVW + c0);
#pragma unroll
            for (int e = 0; e < 4; ++e) { vm2[2 * e] = bflo(a[e]); vm2[2 * e + 1] = bfhi(a[e]); vm1[2 * e] = bflo(b[e]); vm1[2 * e + 1] = bfhi(b[e]); } }
        else {
#pragma unroll
            for (int e = 0; e < 8; ++e) { vm2[e] = 0.f; vm1[e] = 0.f; } }
#pragma unroll
        for (int rr = 0; rr < 4; ++rr) {
            const v4u vv = *(const v4u*)(V + (size_t)(t0 + rr) * CONVW + c0), gg = *(const v4u*)(BG + (size_t)(t0 + rr) * CONVW + c0);
            float v[8], g[8], yv[8];
#pragma unroll
            for (int e = 0; e < 4; ++e) { v[2 * e] = bflo(vv[e]); v[2 * e + 1] = bfhi(vv[e]); g[2 * e] = bflo(gg[e]); g[2 * e + 1] = bfhi(gg[e]); }
#pragma unroll
            for (int e = 0; e < 8; ++e) { yv[e] = g[e] * (w0[e] * vm2[e] + w1[e] * vm1[e] + w2[e] * v[e]); vm2[e] = vm1[e]; vm1[e] = v[e]; }
            v4u o; o.x = pk2(yv[0], yv[1]); o.y = pk2(yv[2], yv[3]); o.z = pk2(yv[4], yv[5]); o.w = pk2(yv[6], yv[7]);
            *(v4u*)(Y + (size_t)(t0 + rr) * D + c0) = o;
        }
    }
}

constexpr int SK_STRIDE = 144, SK_BYTES = 384 * SK_STRIDE, SV_STRIDE = 776, SV_BYTES = 64 * SV_STRIDE, STAB_OFF = SK_BYTES + SV_BYTES;
static_assert(STAB_OFF + 12 * 128 * 4 <= 131072, "swa LDS map");
__device__ __forceinline__ void swa_unit(LAS unsigned char* lds, const LAS float* tab, const bf16* Q, bf16* Y, size_t row0, int tl0, int w, int qh, float sink2, int lane) {
    const int r = lane & 31, hi = lane >> 5;
    bf16x8 qf[4];
#pragma unroll
    for (int s = 0; s < 4; ++s) qf[s] = *(const bf16x8*)(Q + (row0 + r) * D + qh * 64 + 16 * s + 8 * hi);
    float m = sink2, l = hi == 0 ? 1.0f : 0.0f; f32x16 o0 = {}, o1 = {};
    const LAS float* tb = tab + qh * 128;
    const int kb0 = tl0 >= 128 ? 0 : (128 - tl0) >> 5;
    for (int kb = kb0; kb < 5; ++kb) {
        const int j0 = 32 * w + 32 * kb;
        f32x16 S = {};
#pragma unroll
        for (int s = 0; s < 4; ++s) { const bf16x8 kf = *(const LAS bf16x8*)(lds + (j0 + r) * SK_STRIDE + (16 * s + 8 * hi) * 2); S = __builtin_amdgcn_mfma_f32_32x32x16_bf16(kf, qf[s], S, 0, 0, 0); }
#pragma unroll
        for (int i = 0; i < 16; ++i) { const int krow = (i & 3) + 8 * (i >> 2) + 4 * hi; const int dist = 128 - 32 * kb + r - krow;
            S[i] = ((unsigned)dist < 128u) ? S[i] + tb[dist & 127] : -1e30f; }
        bf16x8 p0, p1; softmax_block(S, m, l, o0, o1, p0, p1);
#pragma unroll
        for (int s = 0; s < 2; ++s) {
            const bf16x8 pb = s ? p1 : p0;
#pragma unroll
            for (int db = 0; db < 2; ++db) {
                const LAS unsigned char* vp = lds + SK_BYTES + (db * 32 + r) * SV_STRIDE + (j0 + 16 * s + 4 * hi) * 2;
                const s16x4 a = *(const LAS s16x4*)vp, c = *(const LAS s16x4*)(vp + 16);
                const bf16x8 vf = (bf16x8){a[0], a[1], a[2], a[3], c[0], c[1], c[2], c[3]};
                if (db == 0) o0 = __builtin_amdgcn_mfma_f32_32x32x16_bf16(vf, pb, o0, 0, 0, 0); else o1 = __builtin_amdgcn_mfma_f32_32x32x16_bf16(vf, pb, o1, 0, 0, 0);
            }
        }
    }
    attn_store(o0, o1, l, Y + (row0 + r) * D + qh * 64, hi);
}
__device__ __forceinline__ void swa_phase(LAS unsigned char* lds, const float* rel_bias, const float* sinks, const bf16* Q, const bf16* KB, const bf16* VT, bf16* Y, int tid, int wave, int lane) {
    LAS float* tab = (LAS float*)(lds + STAB_OFF);
    for (int i = tid; i < 12 * 128; i += NTHREADS) { const int h = i >> 7, d = i & 127;
        int bucket = d; if (d >= 16) { bucket = 16 + (int)(log2f((float)d * (1.0f / 16.0f)) * (16.0f / 3.0f)); bucket = bucket > 31 ? 31 : bucket; }
        tab[i] = rel_bias[bucket * 12 + h] * LOG2E; }
    const int G = gridDim.x;
    for (int task = blockIdx.x; task < 4 * (M / 256); task += G) {
        const int kvh = task & 3, chunk = task >> 2, b = chunk / (SEQ / 256), tlc = (chunk % (SEQ / 256)) * 256;
        __syncthreads();
        const int jlo = tlc == 0 ? 128 : 0;
        const bf16* ksrc = KB + ((size_t)b * SEQ + tlc - 128) * 256 + kvh * 64;
        for (int i = tid; i < 384 * 8; i += NTHREADS) { const int j = i >> 3, c = i & 7; if (j >= jlo) *(LAS v4u*)(lds + j * SK_STRIDE + c * 16) = *(const v4u*)(ksrc + (size_t)j * 256 + c * 8); }
        const bf16* vsrc = VT + (size_t)(kvh * 64) * M + (size_t)b * SEQ + tlc - 128;
        for (int i = tid; i < 64 * 96; i += NTHREADS) { const int d = i / 96, c = i % 96; if (c * 4 >= jlo) *(LAS v2u*)(lds + SK_BYTES + d * SV_STRIDE + c * 8) = *(const v2u*)(vsrc + (size_t)d * M + c * 4); }
        __syncthreads();
        const int tl0 = tlc + wave * 32; const size_t row0 = (size_t)b * SEQ + tl0;
        for (int g = 0; g < 3; ++g) { const int qh = kvh * 3 + g; swa_unit(lds, tab, Q, Y, row0, tl0, wave, qh, sinks[qh] * LOG2E, lane); }
    }
    __syncthreads();
}

__device__ __forceinline__ void final_phase(const bf16* XBs, float* out, const float* g, int gw, int NGW, int lane) {
    const f32x4* gr = (const f32x4*)g + lane;
    for (int m0 = gw; m0 < M; m0 += 4 * NGW) {
        v2u v[4][4];
#pragma unroll
        for (int q = 0; q < 4; ++q) { const v2u* xr = (const v2u*)(XBs + (size_t)(m0 + q * NGW) * D) + lane;
#pragma unroll
            for (int j = 0; j < 4; ++j) v[q][j] = xr[64 * j]; }
#pragma unroll
        for (int q = 0; q < 4; ++q) { f32x4* orow = (f32x4*)(out + (size_t)(m0 + q * NGW) * D) + lane; f32x4 f[4]; float s = 0.f;
#pragma unroll
            for (int j = 0; j < 4; ++j) { f[j] = (f32x4){bflo(v[q][j].x), bfhi(v[q][j].x), bflo(v[q][j].y), bfhi(v[q][j].y)}; s += (f[j].x * f[j].x + f[j].y * f[j].y) + (f[j].z * f[j].z + f[j].w * f[j].w); }
            const float rstd = 1.0f / sqrtf(wave_sum(s) * (1.0f / D) + EPS);
#pragma unroll
            for (int j = 0; j < 4; ++j) orow[64 * j] = f[j] * rstd * gr[64 * j]; }
    }
}

#define XB_TMO      128
#define XB_XCNT(j)  (256  + 64 * (j))
#define XB_XSUB(j)  (1280 + 64 * (j))
#define XB_XGEN(j)  (2304 + 64 * (j))
#define XB_TOP      3328
#define XB_TOPGEN   3392
#define XCD_BAR_WORDS 3456
#define XB_SPIN_CAP (1u << 18)

__device__ __forceinline__ unsigned xb_ld(unsigned* p)              { return __hip_atomic_load(p, __ATOMIC_RELAXED, __HIP_MEMORY_SCOPE_AGENT); }
__device__ __forceinline__ unsigned xb_add(unsigned* p, unsigned v) { return __hip_atomic_fetch_add(p, v, __ATOMIC_RELAXED, __HIP_MEMORY_SCOPE_AGENT); }
__device__ __forceinline__ unsigned xb_xcc_id() { return (unsigned)__builtin_amdgcn_s_getreg((3 << 11) | 20) & 0xFu; }
#define XB_SPIN(cond, bar) do { unsigned _sp = 0; while (cond) { __builtin_amdgcn_s_sleep(1); \
    if ((++_sp & 255u) == 0u) { if (xb_ld(&(bar)[XB_TMO])) break; if (_sp > XB_SPIN_CAP) { atomicAdd(&(bar)[XB_TMO], 1u); break; } } } } while (0)

struct XcdBarrier {
    unsigned* bar; unsigned x;
    volatile LAS unsigned* st;
};

__device__ __forceinline__ XcdBarrier xcd_barrier_post(unsigned* bar, volatile LAS unsigned* st) {
    XcdBarrier b; b.bar = bar; b.x = xb_xcc_id(); b.st = st;
    if (threadIdx.x == 0) (void)xb_add(&bar[XB_XCNT(b.x)], 1u);
    return b;
}
__device__ __forceinline__ void xcd_barrier_complete(unsigned* bar, unsigned x, unsigned& nloc, unsigned& nx) {
    const unsigned G = gridDim.x * gridDim.y * gridDim.z;
    unsigned sum, cnt, mine, sp = 0u;
    for (;;) {
        sum = 0u; cnt = 0u; mine = 0u;
#pragma unroll
        for (unsigned j = 0; j < 16; ++j) { const unsigned c = xb_ld(&bar[XB_XCNT(j)]); sum += c; cnt += (c > 0u) ? 1u : 0u; mine = (j == x) ? c : mine; }
        if (sum == G) break;
        __builtin_amdgcn_s_sleep(1);
        if ((++sp & 255u) == 0u) { if (xb_ld(&bar[XB_TMO])) break; if (sp > XB_SPIN_CAP) { atomicAdd(&bar[XB_TMO], 1u); break; } }
    }
    nloc = mine > 0u ? mine : 1u; nx = cnt > 0u ? cnt : 1u;
}

__device__ __forceinline__ void xcd_barrier(const XcdBarrier& b) {
    asm volatile("s_waitcnt vmcnt(0)" ::: "memory");
    __syncthreads();
    if (threadIdx.x == 0) {
        unsigned* bar = b.bar;
        __builtin_amdgcn_s_waitcnt(0);
        unsigned nloc = b.st[0], nx = b.st[1];
        if (nloc == 0u) { xcd_barrier_complete(bar, b.x, nloc, nx); b.st[0] = nloc; b.st[1] = nx; }
        const unsigned old = xb_add(&bar[XB_XSUB(b.x)], 1u);
        const unsigned gen = old / nloc;
        if (old + 1u == (gen + 1u) * nloc) {
            __builtin_amdgcn_fence(__ATOMIC_RELEASE, "agent");
            asm volatile("s_waitcnt vmcnt(0)" ::: "memory");
            const unsigned og = xb_add(&bar[XB_TOP], 1u);
            const unsigned tg = og / nx;
            if (og + 1u == (tg + 1u) * nx) xb_add(&bar[XB_TOPGEN], 1u);
            else XB_SPIN(xb_ld(&bar[XB_TOPGEN]) == tg, bar);
            __builtin_amdgcn_fence(__ATOMIC_ACQUIRE, "agent");
            xb_add(&bar[XB_XGEN(b.x)], 1u);
            asm volatile("s_waitcnt vmcnt(0)" ::: "memory");
        } else {
            XB_SPIN(xb_ld(&bar[XB_XGEN(b.x)]) == gen, bar);
            __builtin_amdgcn_fence(__ATOMIC_ACQUIRE, "agent");
            asm volatile("s_waitcnt vmcnt(0)" ::: "memory");
        }
    }
    __syncthreads();
}

#define GRID_SYNC() do { XcdBarrier b_; b_.bar = (unsigned*)(kargs()->ws + WS_CTL); b_.x = xb_xcc_id(); b_.st = (volatile LAS unsigned*)(lds + 131072) + 8; xcd_barrier(b_); } while (0)
enum StepType { ST_AIN = 0, ST_MIXA, ST_RES, ST_UP, ST_KVQ, ST_ATTB, ST_FINAL };
__global__ void __launch_bounds__(NTHREADS, 2) yoco_fwd(Args a) {
    extern __shared__ __attribute__((aligned(16))) unsigned char lds_raw[];
    cg::grid_group grid = cg::this_grid();
    LAS unsigned char* lds = (LAS unsigned char*)lds_raw;
    const int tid = threadIdx.x, lane = tid & 63, wave = __builtin_amdgcn_readfirstlane(tid >> 6), G = gridDim.x;
    const int gw = blockIdx.x * NWAVES + wave, NGW = G * NWAVES;
    { unsigned char* ws = kargs()->ws;

    volatile LAS unsigned* MISC = (volatile LAS unsigned*)(lds + 131072);
    if (tid < 64) MISC[tid] = 0u;
    __syncthreads();
    (void)xcd_barrier_post((unsigned*)(ws + WS_CTL), MISC + 8);

    prologue(lds, gw, NGW, wave, lane);
    GRID_SYNC(); }

    for (int step = 0; step < 21; ++step) {
        int type, layer, sub = 0;
        if (step < 20) { layer = step / 5; const int k = step % 5; sub = (k == 4);
            type = (k == 0) ? (layer < 2 ? ST_AIN : ST_KVQ) : (k == 1) ? (layer < 2 ? ST_MIXA : ST_ATTB) : (k == 3) ? ST_UP : ST_RES; }
        else { type = ST_FINAL; layer = 3; }
        int tidv = threadIdx.x; asm volatile("" : "+v"(tidv));
        const int lanev = tidv & 63, wavev = __builtin_amdgcn_readfirstlane(tidv >> 6);
        const CArgsP ka = kargs(); unsigned char* ws = ka->ws;
        float* ssqp = (float*)(ws + WS_SSQ); bf16* XB = (bf16*)(ws + WS_XB); bf16* Hb = (bf16*)(ws + WS_H); bf16* Yb = (bf16*)(ws + WS_Y); bf16* MK = (bf16*)(ws + WS_MK); bf16* MVT = (bf16*)(ws + WS_MVT);
        switch (type) {
        case ST_AIN: {
            if (layer == 0) {
                { pg8::Gemm g{(const bf16*)(ws + WS_MEMN), (const bf16*)(ws + WS_WMEMKV), 512, 1024, D}; pg8::StaticOrder S; S.init(512, 1024, G, (int)blockIdx.x);
                  pg8::EpiRowScale E{MK, 256, (const LAS float*)nullptr, 1.0f, (size_t)512 * 256, nullptr, 0};
                  pg8::gemm_phase<pg8::EpiRowScale, pg8::StaticOrder, true, true>(lds, g, S, E, tidv); }
                { pg8::Gemm g{(const bf16*)(ws + WS_WMEMKV) + (size_t)1024 * D, (const bf16*)(ws + WS_MEMN), 1024, 512, D}; pg8::StaticOrder S; S.init(1024, 512, G, (int)((blockIdx.x + G - 8) % G));
                  pg8::EpiVT E{MVT, 256, nullptr, (size_t)2 * 65536, (size_t)65536};
                  pg8::gemm_phase<pg8::EpiVT, pg8::StaticOrder, true, true>(lds, g, S, E, tidv); }
            }
            pg8::Gemm g{XB, (const bf16*)(ws + WS_WAIN) + (size_t)layer * APROJ * D, M, APROJ, D}; pg8::StaticOrder S; S.init(M, APROJ, G, (int)blockIdx.x);
            pg8::fill_rstd(lds, ssqp, S, tidv);
            pg8::EpiAIn E{(bf16*)(ws + WS_V), (bf16*)(ws + WS_BG), (bf16*)(ws + WS_QM), (const LAS float*)(lds + pg8::RSTAB_OFF), QSCALE};
            pg8::gemm_phase<pg8::EpiAIn, pg8::StaticOrder, true, true>(lds, g, S, E, tidv);
        } break;
        case ST_MIXA: {
            conv_phase((const bf16*)(ws + WS_V), (const bf16*)(ws + WS_BG), ka->in[I_A_CONV_W] + (size_t)layer * 3 * CONVW, Yb, blockIdx.x * NTHREADS + tidv, G * NTHREADS);
            mem_attn_phase(lds, MK, MVT, layer, (const bf16*)(ws + WS_QM), 256, 0, Yb, tidv, wavev, lanev);
        } break;
        case ST_RES: {
            const bf16* A = sub ? Hb : Yb; const int K = sub ? DFF : D;
            const bf16* Bt = sub ? (const bf16*)(ws + WS_WDOWN) + (size_t)layer * D * DFF : (layer < 2 ? (const bf16*)(ws + WS_WAOUT) + (size_t)layer * D * D : (const bf16*)(ws + WS_WBOUT) + (size_t)(layer - 2) * D * D);
            pg8::Gemm g{A, Bt, M, D, K}; pg8::StaticOrder S; S.init(M, D, G, (int)blockIdx.x);
            pg8::EpiRes E{XB, ssqp};
            pg8::gemm_phase<pg8::EpiRes, pg8::StaticOrder, true, true>(lds, g, S, E, tidv);
        } break;
        case ST_UP: {
            pg8::Gemm g{XB, (const bf16*)(ws + WS_WUP) + (size_t)layer * 2 * DFF * D, M, 2 * DFF, D}; pg8::StaticOrder S; S.init(M, 2 * DFF, G, (int)blockIdx.x);
            pg8::fill_rstd(lds, ssqp, S, tidv);
            pg8::EpiSwiglu E{Hb, (const LAS float*)(lds + pg8::RSTAB_OFF)};
            pg8::gemm_phase<pg8::EpiSwiglu, pg8::StaticOrder, true, true>(lds, g, S, E, tidv);
        } break;
        case ST_KVQ: {
            if (layer == 2) {
                pg8::Gemm g{(const bf16*)(ws + WS_WKV), XB, 256, M, D}; pg8::StaticOrder S; S.init(256, M, G, (int)((blockIdx.x + G - 128) % G));
                pg8::EpiVT E{(bf16*)(ws + WS_VT), M, ssqp, (size_t)0, (size_t)256};
                pg8::gemm_phase<pg8::EpiVT, pg8::StaticOrder, true, true>(lds, g, S, E, tidv);
            }
            const int pn0 = layer == 2 ? 1 : 0;
            pg8::Gemm g{XB, layer == 2 ? (const bf16*)(ws + WS_WKV) + (size_t)256 * D : (const bf16*)(ws + WS_WBQ) + (size_t)D * D, M, D + 256 * pn0, D}; pg8::StaticOrder S; S.init(M, D + 256 * pn0, G, (int)blockIdx.x);
            pg8::fill_rstd(lds, ssqp, S, tidv);
            pg8::EpiRowScale E{(bf16*)(ws + WS_Q), D, (const LAS float*)(lds + pg8::RSTAB_OFF), QSCALE, (size_t)256, (bf16*)(ws + WS_KB), pn0};
            pg8::gemm_phase<pg8::EpiRowScale, pg8::StaticOrder, true, true>(lds, g, S, E, tidv);
        } break;
        case ST_ATTB: {
            swa_phase(lds, ka->in[I_REL_BIAS], ka->in[I_B_SINKS] + (layer - 2) * 12, (const bf16*)(ws + WS_Q), (const bf16*)(ws + WS_KB), (const bf16*)(ws + WS_VT), Yb, tidv, wavev, lanev);
            mem_attn_phase(lds, MK, MVT, layer, (const bf16*)(ws + WS_Q), D, CONVW, Yb, tidv, wavev, lanev);
        } break;
        default: {
            final_phase(XB, ka->out, ka->in[I_FINAL_NORM], blockIdx.x * NWAVES + wavev, NGW, lanev);
        } break;
        }
        if (step < 20) GRID_SYNC();
    }
    if (kargs()->out == nullptr) grid.sync();
}

extern "C" void kernel_launch(void* const* d_in, const int* in_sizes, int n_in, void* d_out, int out_size, void* d_ws, size_t ws_size, hipStream_t stream) {
    static int grid = 0;
    if (grid == 0) {
        if (n_in != 19 || out_size != M * D || ws_size < WS_END) { fprintf(stderr, "kernel_launch: unexpected shapes (n_in %d out %d ws %zu)\n", n_in, out_size, ws_size); grid = -1; return; }
        int dev = 0, cus = 0, per_cu = 0;
        if (hipGetDevice(&dev) != hipSuccess || hipDeviceGetAttribute(&cus, hipDeviceAttributeMultiprocessorCount, dev) != hipSuccess) { grid = -1; return; }
        if (hipFuncSetAttribute((const void*)yoco_fwd, hipFuncAttributeMaxDynamicSharedMemorySize, LDS_BYTES) != hipSuccess) { fprintf(stderr, "kernel_launch: hipFuncSetAttribute failed\n"); grid = -1; return; }
        if (hipOccupancyMaxActiveBlocksPerMultiprocessor(&per_cu, (const void*)yoco_fwd, NTHREADS, LDS_BYTES) != hipSuccess || per_cu < 1) per_cu = 1;
        (void)hipGetLastError();
        grid = cus * per_cu;
        if (grid != 256) { fprintf(stderr, "kernel_launch: built for a 256-workgroup grid (one per CU), got %d\n", grid); grid = -1; return; }
    }
    if (grid < 0) return;
    if (hipMemsetAsync((char*)d_ws + WS_CTL, 0, CTL_BYTES, stream) != hipSuccess) { fprintf(stderr, "kernel_launch: memset failed\n"); return; }
    Args a{};
    for (int i = 0; i < 19; ++i) a.in[i] = (const float*)d_in[i];
    a.out = (float*)d_out; a.ws = (unsigned char*)d_ws;
    void* args[] = {&a};
    const hipError_t e = hipLaunchCooperativeKernel((const void*)yoco_fwd, dim3(grid), dim3(NTHREADS), args, LDS_BYTES, stream);
    if (e != hipSuccess) fprintf(stderr, "kernel_launch: cooperative launch failed: %s (grid %d)\n", hipGetErrorString(e), grid);
}
```

```cpp
#include <hip/hip_runtime.h>
#include <hip/hip_cooperative_groups.h>
#include <cstdio>
#include <cstdint>
namespace cg = cooperative_groups;
namespace pg8 {
#define PG8_LAS __attribute__((address_space(3)))
typedef unsigned short bf16_t;
typedef short bf16x8 __attribute__((ext_vector_type(8)));
typedef float f32x4 __attribute__((ext_vector_type(4)));
typedef unsigned u32x4 __attribute__((ext_vector_type(4)));
constexpr int BM = 256, BK = 64, HALF = 128, HTB = HALF * BK * 2  , STAGE_BYTES = 8 * HTB, NXCD = 8, WGM = 4;

__host__ __device__ __forceinline__ int lds_byte(int r, int c) { const int st = (r >> 4) * 2 + (c >> 5), rr = r & 15, cc = c & 31, ob = rr * 64 + cc * 2; return st * 1024 + (ob ^ (((ob >> 9) & 1) << 5)); }
__host__ __device__ __forceinline__ void stage_rc(int b, int& R, int& C) { const int st = b / 1024, sb = b % 1024, swz = sb ^ (((sb >> 9) & 1) << 5); R = (st >> 1) * 16 + swz / 64; C = (st & 1) * 32 + (swz % 64) / 2; }
__host__ __device__ __forceinline__ int perm32(int rho) { const int n = rho >> 4, i = rho & 15; return 8 * (i >> 2) + 4 * n + (i & 3); }

struct Unit { int pm, pn, ui; };
struct Gemm { const bf16_t* A; const bf16_t* Bt; int M, N, K; };

struct StaticOrder {
    int nM, nN, nwg, G, c;
    __host__ __device__ void init(int M, int N, int G_, int c_) { nM = M / BM; nN = N / BM; nwg = nM * nN; G = G_; c = c_; }
    __host__ __device__ bool next(int i, Unit& u) const {
        const long L = (long)i * G + c; if (L >= nwg) return false;
        int wgid = (int)L; { const int q = nwg / NXCD, r = nwg % NXCD, xcd = wgid % NXCD, off = wgid / NXCD; wgid = (xcd < r ? xcd * (q + 1) : r * (q + 1) + (xcd - r) * q) + off; }
        const int nig = WGM * nN, gid = wgid / nig, fm = gid * WGM, gsz = (nM - fm) < WGM ? (nM - fm) : WGM;
        u.pm = fm + ((wgid % nig) % gsz); u.pn = (wgid % nig) / gsz; u.ui = i; return true;
    }
    __device__ __forceinline__ void a_ready(const Unit&) const {}
    __device__ __forceinline__ void done(const Unit&) const {}
};
typedef float f32x2_t __attribute__((ext_vector_type(2))); typedef __bf16 bf16x2_t __attribute__((ext_vector_type(2)));
__device__ __forceinline__ unsigned cvt_pk_bf16(float lo, float hi) { f32x2_t v = {lo, hi}; bf16x2_t b = __builtin_convertvector(v, bf16x2_t); return __builtin_bit_cast(unsigned, b); }
typedef float f32x2 __attribute__((ext_vector_type(2)));
typedef unsigned u32x2 __attribute__((ext_vector_type(2)));
constexpr int DMODEL = 1024;
__device__ __forceinline__ float row_rstd(const float* ssqp, int row) {
    const f32x4* p = (const f32x4*)(ssqp + (size_t)row * 16);
    const f32x4 a = p[0], b = p[1], c = p[2], d = p[3];
    const f32x4 s = (a + b) + (c + d);
    const float t = (s[0] + s[1]) + (s[2] + s[3]);
    return __builtin_amdgcn_rsqf(t * (1.0f / 1024.0f) + 1e-5f);
}
constexpr int RSTAB_OFF = 132096;
template <class Sched> __device__ __forceinline__ void fill_rstd(PG8_LAS unsigned char* lds, const float* ssqp, const Sched& S, int tid) {
    PG8_LAS float* tab = (PG8_LAS float*)(lds + RSTAB_OFF); Unit u; const int row = tid >> 1, half = tid & 1;
    for (int i = 0; S.next(i, u); ++i) { const f32x4* p = (const f32x4*)(ssqp + (size_t)(u.pm * BM + row) * 16 + half * 8); const f32x4 a = p[0], b = p[1], s4 = a + b; float s = (s4[0] + s4[1]) + (s4[2] + s4[3]);
        s += __shfl_xor(s, 1); if (half == 0) tab[i * 256 + row] = __builtin_amdgcn_rsqf(s * (1.0f / 1024.0f) + 1e-5f); }
    __syncthreads();
}
__device__ __forceinline__ u32x4 pack8(f32x4 v0, f32x4 v1) { u32x4 w; w.x = cvt_pk_bf16(v0[0], v0[1]); w.y = cvt_pk_bf16(v0[2], v0[3]); w.z = cvt_pk_bf16(v1[0], v1[1]); w.w = cvt_pk_bf16(v1[2], v1[3]); return w; }
__device__ __forceinline__ unsigned short f2bf1(float f) { unsigned u = __builtin_bit_cast(unsigned, f); return (unsigned short)((u + 0x7fffu + ((u >> 16) & 1u)) >> 16); }

struct EpiAIn {
    static constexpr bool PERM = true, AFTER_DRAIN = false;
    bf16_t *V, *BG, *QM; const PG8_LAS float* rstab; float qscale;
    __device__ __forceinline__ void operator()(const f32x4 (&acc)[2][2][4][2], const Unit& u, int wr, int wc, int fr, int fq) const {
        const int row0 = u.pm * BM + wr * 64 + fr, cl = wc * 32 + 8 * fq; const PG8_LAS float* rt = rstab + u.ui * 256 + wr * 64 + fr;
        if (u.pn < 6) {
#pragma unroll
            for (int ai = 0; ai < 2; ++ai)
#pragma unroll
                for (int m = 0; m < 4; ++m) { const int row = row0 + ai * HALF + m * 16; const float r = rt[ai * HALF + m * 16], r2 = r * r;
                    *(u32x4*)(V + (size_t)row * 768 + u.pn * 128 + cl) = pack8(acc[ai][0][m][0] * acc[ai][1][m][0] * r2, acc[ai][0][m][1] * acc[ai][1][m][1] * r2); }
        } else if (u.pn < 9) {
#pragma unroll
            for (int ai = 0; ai < 2; ++ai)
#pragma unroll
                for (int m = 0; m < 4; ++m) { const int row = row0 + ai * HALF + m * 16; const float r = rt[ai * HALF + m * 16];
#pragma unroll
                    for (int bj = 0; bj < 2; ++bj) *(u32x4*)(BG + (size_t)row * 768 + (u.pn - 6) * 256 + bj * HALF + cl) = pack8(acc[ai][bj][m][0] * r, acc[ai][bj][m][1] * r); }
        } else {
#pragma unroll
            for (int ai = 0; ai < 2; ++ai)
#pragma unroll
                for (int m = 0; m < 4; ++m) { const int row = row0 + ai * HALF + m * 16; const float r = rt[ai * HALF + m * 16] * qscale;
#pragma unroll
                    for (int bj = 0; bj < 2; ++bj) *(u32x4*)(QM + (size_t)row * 256 + bj * HALF + cl) = pack8(acc[ai][bj][m][0] * r, acc[ai][bj][m][1] * r); }
        }
    }
};
struct EpiRowScale {
    static constexpr bool PERM = true, AFTER_DRAIN = false;
    bf16_t* O; int ldc; const PG8_LAS float* rstab; float scale; size_t pn_stride; bf16_t* KO; int pn0;
    __device__ __forceinline__ void operator()(const f32x4 (&acc)[2][2][4][2], const Unit& u, int wr, int wc, int fr, int fq) const {
        const int row0 = u.pm * BM + wr * 64 + fr, cl = wc * 32 + 8 * fq; const bool isk = u.pn < pn0;
        bf16_t* ob = isk ? KO + cl : O + (size_t)(u.pn - pn0) * pn_stride + cl; const int ld = isk ? 256 : ldc; const float sc = isk ? 1.0f : scale;
        const PG8_LAS float* rt = rstab + u.ui * 256 + wr * 64 + fr;
#pragma unroll
        for (int ai = 0; ai < 2; ++ai)
#pragma unroll
            for (int m = 0; m < 4; ++m) { const int row = row0 + ai * HALF + m * 16; const float r = rstab ? rt[ai * HALF + m * 16] * sc : sc;
#pragma unroll
                for (int bj = 0; bj < 2; ++bj) *(u32x4*)(ob + (size_t)row * ld + bj * HALF) = pack8(acc[ai][bj][m][0] * r, acc[ai][bj][m][1] * r); }
    }
};
struct EpiVT {
    static constexpr bool PERM = true, AFTER_DRAIN = true;
    bf16_t* O; int ld; const float* ssqp; size_t pm_stride, pn_stride;
    __device__ __forceinline__ void fused(f32x4 (&acc)[2][2][4][2], const Unit& u, int wr, int wc, int fr, int fq, PG8_LAS unsigned char* lds, int wid, int lane) const {
        PG8_LAS float* rs = (PG8_LAS float*)lds;
        { const int t = wid * 64 + lane, tok = t >> 1, half = t & 1; float r = 1.0f;
          if (ssqp) { const f32x4* p = (const f32x4*)(ssqp + (size_t)(u.pn * BM + tok) * 16 + half * 8); const f32x4 a = p[0], b = p[1], s4 = a + b; float s = (s4[0] + s4[1]) + (s4[2] + s4[3]);
              s += __shfl_xor(s, 1); r = __builtin_amdgcn_rsqf(s * (1.0f / 1024.0f) + 1e-5f); }
          if (half == 0) rs[tok] = r; }
        asm volatile("s_waitcnt lgkmcnt(0)" ::: "memory"); __builtin_amdgcn_s_barrier(); asm volatile("" ::: "memory");
        const int rl0 = wr * 64 + fr, cl = wc * 32 + 8 * fq; bf16_t* ob = O + (size_t)u.pm * pm_stride + (size_t)u.pn * pn_stride + cl;
#pragma unroll
        for (int bj = 0; bj < 2; ++bj) {
            const f32x4 s0 = *(const PG8_LAS f32x4*)(rs + bj * HALF + cl), s1 = *(const PG8_LAS f32x4*)(rs + bj * HALF + cl + 4);
#pragma unroll
            for (int ai = 0; ai < 2; ++ai)
#pragma unroll
                for (int m = 0; m < 4; ++m) *(u32x4*)(ob + (size_t)(rl0 + ai * HALF + m * 16) * ld + bj * HALF) = pack8(acc[ai][bj][m][0] * s0, acc[ai][bj][m][1] * s1);
        }
        asm volatile("s_waitcnt lgkmcnt(0)" ::: "memory"); __builtin_amdgcn_s_barrier(); asm volatile("" ::: "memory");
    }
};
struct EpiSwiglu {
    static constexpr bool PERM = true, AFTER_DRAIN = false;
    bf16_t* H; const PG8_LAS float* rstab;
    __device__ __forceinline__ void operator()(const f32x4 (&acc)[2][2][4][2], const Unit& u, int wr, int wc, int fr, int fq) const {
        const int row0 = u.pm * BM + wr * 64 + fr, cl = u.pn * 128 + wc * 32 + 8 * fq; const PG8_LAS float* rt = rstab + u.ui * 256 + wr * 64 + fr;
#pragma unroll
        for (int ai = 0; ai < 2; ++ai)
#pragma unroll
            for (int m = 0; m < 4; ++m) { const int row = row0 + ai * HALF + m * 16; const float r = rt[ai * HALF + m * 16], nr = r * -1.4426950408889634f, r2 = r * r;
                f32x4 hv[2];
#pragma unroll
                for (int n = 0; n < 2; ++n) { const f32x4 ag = acc[ai][0][m][n], au = acc[ai][1][m][n]; const f32x4 t = ag * nr, gu = (ag * au) * r2; f32x4 d;
#pragma unroll
                    for (int j = 0; j < 4; ++j) d[j] = __builtin_amdgcn_rcpf(1.0f + __builtin_amdgcn_exp2f(t[j]));
                    hv[n] = gu * d; }
                __builtin_nontemporal_store(pack8(hv[0], hv[1]), (u32x4*)(H + (size_t)row * 2816 + cl)); }
    }
};
struct EpiRes {
    static constexpr bool PERM = true, AFTER_DRAIN = false;
    bf16_t* xb; float* ssqp;
    __device__ __forceinline__ void operator()(const f32x4 (&acc)[2][2][4][2], const Unit& u, int wr, int wc, int fr, int fq) const {
        const int row0 = u.pm * BM + wr * 64 + fr, cl = u.pn * BM + wc * 32 + 8 * fq;
#pragma unroll
        for (int ai = 0; ai < 2; ++ai)
#pragma unroll
            for (int m = 0; m < 4; ++m) { const int row = row0 + ai * HALF + m * 16; bf16_t* xp = xb + (size_t)row * DMODEL + cl; float q = 0.f;
#pragma unroll
                for (int bj = 0; bj < 2; ++bj) { const u32x4 o = *(const u32x4*)(xp + bj * HALF);
                    const f32x4 b0 = {__builtin_bit_cast(float, o.x << 16), __builtin_bit_cast(float, o.x & 0xffff0000u), __builtin_bit_cast(float, o.y << 16), __builtin_bit_cast(float, o.y & 0xffff0000u)};
                    const f32x4 b1 = {__builtin_bit_cast(float, o.z << 16), __builtin_bit_cast(float, o.z & 0xffff0000u), __builtin_bit_cast(float, o.w << 16), __builtin_bit_cast(float, o.w & 0xffff0000u)};
                    const f32x4 x0 = b0 + acc[ai][bj][m][0], x1 = b1 + acc[ai][bj][m][1];
                    *(u32x4*)(xp + bj * HALF) = pack8(x0, x1);
                    q += (x0[0] * x0[0] + x0[1] * x0[1]) + (x0[2] * x0[2] + x0[3] * x0[3]) + (x1[0] * x1[0] + x1[1] * x1[1]) + (x1[2] * x1[2] + x1[3] * x1[3]); }
                q += __shfl_xor(q, 16); q += __shfl_xor(q, 32);
                if (fq == 0) ssqp[(size_t)row * 16 + u.pn * 4 + wc] = q; }
    }
};
template <class Epi, class Sched, bool ALIGN_EPI = false, bool SP2 = false>
__device__ __forceinline__ void gemm_phase(PG8_LAS unsigned char* lds, const Gemm g, const Sched& S, const Epi& E, const int tid) {
    const int wid = __builtin_amdgcn_readfirstlane(tid >> 6), lane = tid & 63, wr = wid >> 2, wc = wid & 3, fr = lane & 15, fq = lane >> 4;
    const int K = g.K, nt = K / BK;
    unsigned voffA[2], voffB[2];
#pragma unroll
    for (int i = 0; i < 2; ++i) { int R, C; stage_rc(tid * 16 + i * 8192, R, C); const int Rb = Epi::PERM ? ((R & ~31) + perm32(R & 31)) : R;
        voffA[i] = (unsigned)(R * K + C) * 2u; voffB[i] = (unsigned)(Rb * K + C) * 2u; }
    const size_t kstep = (size_t)(BK * 2);
    const size_t hstep = (size_t)HALF * K * 2;
    const size_t tstep = 2 * hstep;
    const unsigned ldsw = (unsigned)wid * 1024u;
    const int aoff = lds_byte(wr * 64 + fr, fq * 8), boff = lds_byte(wc * 32 + fr, fq * 8);
#define PG8_SA(b, h) (((b) * 2 + (h)) * HTB)
#define PG8_SB(b, h) ((4 + (b) * 2 + (h)) * HTB)
#define PG8_STAGE(bufoff, gbase, voff) do { _Pragma("unroll") for (int _i = 0; _i < 2; ++_i) \
        __builtin_amdgcn_global_load_lds((const unsigned*)((const char*)(gbase) + (voff)[_i]), (PG8_LAS unsigned*)(lds + (bufoff) + ldsw + _i * 8192), 16, 0, 0); } while (0)
#define PG8_LDA(dst, b, h) do { _Pragma("unroll") for (int m = 0; m < 4; ++m) _Pragma("unroll") for (int k = 0; k < 2; ++k) dst[m][k] = *(const PG8_LAS bf16x8*)(lds + PG8_SA(b, h) + aoff + m * 2048 + k * 1024); } while (0)
#define PG8_LDB(dst, b, h) do { _Pragma("unroll") for (int n = 0; n < 2; ++n) _Pragma("unroll") for (int k = 0; k < 2; ++k) dst[n][k] = *(const PG8_LAS bf16x8*)(lds + PG8_SB(b, h) + boff + n * 2048 + k * 1024); } while (0)
#define PG8_MMA(ai, bj, At, Bt) do { __builtin_amdgcn_s_setprio(1); _Pragma("unroll") for (int m = 0; m < 4; ++m) _Pragma("unroll") for (int n = 0; n < 2; ++n) _Pragma("unroll") for (int k = 0; k < 2; ++k) \
        acc[ai][bj][m][n] = __builtin_amdgcn_mfma_f32_16x16x32_bf16(Bt[n][k], At[m][k], acc[ai][bj][m][n], 0, 0, 0); __builtin_amdgcn_s_setprio(0); } while (0)
#define PG8_WAIT_V(n) asm volatile("s_waitcnt vmcnt(" #n ")" ::: "memory")
#define PG8_WAIT_L(n) asm volatile("s_waitcnt lgkmcnt(" #n ")" ::: "memory")
#define PG8_BAR __builtin_amdgcn_s_barrier()
#define PG8_SCHED __builtin_amdgcn_sched_barrier(0)
    Unit cur, nxt; int ui = 0;
    if (!S.next(0, cur)) return;
    f32x4 acc[2][2][4][2];
#pragma unroll
    for (int a = 0; a < 2; ++a)
#pragma unroll
        for (int b = 0; b < 2; ++b)
#pragma unroll
            for (int m = 0; m < 4; ++m)
#pragma unroll
                for (int n = 0; n < 2; ++n) acc[a][b][m][n] = (f32x4){0.f, 0.f, 0.f, 0.f};
    bf16x8 At[4][2], B0[2][2], B1[2][2];
    const char* cA = (const char*)g.A + (size_t)cur.pm * tstep; const char* cB = (const char*)g.Bt + (size_t)cur.pn * tstep;
    S.a_ready(cur);
    if constexpr (SP2) {
        PG8_STAGE(PG8_SB(0, 0), cB, voffB); PG8_STAGE(PG8_SB(0, 1), cB + hstep, voffB); PG8_STAGE(PG8_SA(0, 0), cA, voffA); PG8_STAGE(PG8_SA(0, 1), cA + hstep, voffA);
        if (wr == 1) PG8_BAR;
        PG8_WAIT_V(2); PG8_BAR;
        PG8_STAGE(PG8_SB(1, 0), cB + kstep, voffB); PG8_STAGE(PG8_SA(1, 0), cA + kstep, voffA); PG8_STAGE(PG8_SB(1, 1), cB + hstep + kstep, voffB);
        PG8_WAIT_V(6); PG8_BAR;
    } else {
        PG8_STAGE(PG8_SB(0, 0), cB, voffB); PG8_STAGE(PG8_SA(0, 0), cA, voffA); PG8_STAGE(PG8_SB(0, 1), cB + hstep, voffB); PG8_STAGE(PG8_SA(0, 1), cA + hstep, voffA);
        if (wr == 1) PG8_BAR;
        PG8_WAIT_V(4); PG8_BAR;
        PG8_STAGE(PG8_SB(1, 0), cB + kstep, voffB); PG8_STAGE(PG8_SA(1, 0), cA + kstep, voffA); PG8_STAGE(PG8_SB(1, 1), cB + hstep + kstep, voffB);
        PG8_WAIT_V(6); PG8_BAR;
    }
    for (;;) {
        const bool has_next = S.next(ui + 1, nxt);
        const char* nA = has_next ? (const char*)g.A + (size_t)nxt.pm * tstep : cA; const char* nB = has_next ? (const char*)g.Bt + (size_t)nxt.pn * tstep : cB;
        for (int t = 0; t < nt; t += 2) {
            const bool last = (t == nt - 2);
            const char* a1 = cA + (size_t)(t + 1) * kstep;
            const char* a2 = last ? nA : cA + (size_t)(t + 2) * kstep; const char* b2 = last ? nB : cB + (size_t)(t + 2) * kstep;
            const char* a3 = a2 + kstep; const char* b3 = b2 + kstep;
            if (last && has_next) S.a_ready(nxt);
            if constexpr (SP2) {
            PG8_LDB(B0, 0, 0); PG8_LDB(B1, 0, 1); PG8_SCHED; PG8_LDA(At, 0, 0); PG8_STAGE(PG8_SA(1, 1), a1 + hstep, voffA);
            PG8_WAIT_V(8); PG8_WAIT_L(0); PG8_BAR; PG8_MMA(0, 0, At, B0); PG8_MMA(0, 1, At, B1); PG8_BAR; PG8_SCHED;
            PG8_LDA(At, 0, 1); PG8_STAGE(PG8_SB(0, 0), b2, voffB); PG8_STAGE(PG8_SB(0, 1), b2 + hstep, voffB); PG8_STAGE(PG8_SA(0, 0), a2, voffA);
            PG8_WAIT_V(8); PG8_WAIT_L(0); PG8_BAR; PG8_MMA(1, 0, At, B0); PG8_MMA(1, 1, At, B1); PG8_BAR; PG8_SCHED;
            PG8_LDB(B0, 1, 0); PG8_LDB(B1, 1, 1); PG8_SCHED; PG8_LDA(At, 1, 0); PG8_STAGE(PG8_SA(0, 1), a2 + hstep, voffA);
            PG8_WAIT_V(8); PG8_WAIT_L(0); PG8_BAR; PG8_MMA(0, 0, At, B0); PG8_MMA(0, 1, At, B1); PG8_BAR; PG8_SCHED;
            PG8_LDA(At, 1, 1); PG8_STAGE(PG8_SB(1, 0), b3, voffB); PG8_STAGE(PG8_SB(1, 1), b3 + hstep, voffB); PG8_STAGE(PG8_SA(1, 0), a3, voffA);
            PG8_WAIT_V(8); PG8_WAIT_L(0); PG8_BAR; PG8_MMA(1, 0, At, B0); PG8_MMA(1, 1, At, B1); PG8_BAR; PG8_SCHED;
            } else {
            PG8_LDB(B0, 0, 0); PG8_SCHED; PG8_LDA(At, 0, 0); PG8_STAGE(PG8_SA(1, 1), a1 + hstep, voffA);
            PG8_WAIT_L(8); PG8_BAR; PG8_WAIT_L(0); PG8_MMA(0, 0, At, B0); PG8_BAR; PG8_SCHED;
            PG8_LDB(B1, 0, 1); PG8_STAGE(PG8_SB(0, 0), b2, voffB);
            PG8_BAR; PG8_WAIT_L(0); PG8_MMA(0, 1, At, B1); PG8_BAR;
            PG8_LDA(At, 0, 1); PG8_STAGE(PG8_SA(0, 0), a2, voffA);
            PG8_BAR; PG8_WAIT_L(0); PG8_MMA(1, 0, At, B0); PG8_BAR; PG8_SCHED;
            PG8_STAGE(PG8_SB(0, 1), b2 + hstep, voffB);
            PG8_WAIT_V(6); PG8_BAR; PG8_MMA(1, 1, At, B1); PG8_BAR;
            PG8_LDB(B0, 1, 0); PG8_SCHED; PG8_LDA(At, 1, 0); PG8_STAGE(PG8_SA(0, 1), a2 + hstep, voffA);
            PG8_WAIT_L(8); PG8_BAR; PG8_WAIT_L(0); PG8_MMA(0, 0, At, B0); PG8_BAR; PG8_SCHED;
            PG8_LDB(B1, 1, 1); PG8_STAGE(PG8_SB(1, 0), b3, voffB);
            PG8_BAR; PG8_WAIT_L(0); PG8_MMA(0, 1, At, B1); PG8_BAR;
            PG8_LDA(At, 1, 1); PG8_STAGE(PG8_SA(1, 0), a3, voffA);
            PG8_BAR; PG8_WAIT_L(0); PG8_MMA(1, 0, At, B0); PG8_BAR; PG8_SCHED;
            PG8_STAGE(PG8_SB(1, 1), b3 + hstep, voffB);
            PG8_WAIT_V(6); PG8_BAR; PG8_MMA(1, 1, At, B1); PG8_BAR;
            }
        }
        if constexpr (ALIGN_EPI) { if (wr == 0) PG8_BAR; }
        if constexpr (!Epi::AFTER_DRAIN) { E(acc, cur, wr, wc, fr, fq); S.done(cur); }
        if (!has_next) break;
#pragma unroll
        for (int a = 0; a < 2; ++a)
#pragma unroll
            for (int b = 0; b < 2; ++b)
#pragma unroll
                for (int m = 0; m < 4; ++m)
#pragma unroll
                    for (int n = 0; n < 2; ++n) acc[a][b][m][n] = (f32x4){0.f, 0.f, 0.f, 0.f};
        cur = nxt; cA = nA; cB = nB; ++ui;
        if constexpr (ALIGN_EPI) { if (wr == 1) PG8_BAR; }
    }
    PG8_WAIT_V(0);
    if constexpr (!ALIGN_EPI) { if (wr == 0) PG8_BAR; }
    PG8_BAR;
    if constexpr (Epi::AFTER_DRAIN) { E.fused(acc, cur, wr, wc, fr, fq, lds, wid, lane); S.done(cur); }
#undef PG8_SA
#undef PG8_SB
#undef PG8_STAGE
#undef PG8_LDA
#undef PG8_LDB
#undef PG8_MMA
#undef PG8_WAIT_V
#undef PG8_WAIT_L
#undef PG8_BAR
#undef PG8_SCHED
}
}

constexpr int BATCH = 2, SEQ = 16384, D = 1024, M = BATCH * SEQ, NMEM = 256, DFF = 2816, CONVW = 768, APROJ = 2560;
constexpr int NWAVES = 8, NTHREADS = 512;
constexpr float LOG2E = 1.4426950408889634f, QSCALE = 0.125f * LOG2E, EPS = 1e-5f;

constexpr size_t MiB = 1u << 20;
constexpr size_t WS_SSQ = 0;
constexpr size_t WS_MEMN = 2 * MiB;
constexpr size_t WS_MK = 3 * MiB;
constexpr size_t WS_MVT = 4 * MiB;
constexpr size_t WS_WAIN = 5 * MiB;
constexpr size_t WS_WAOUT = 15 * MiB;
constexpr size_t WS_WKV = 19 * MiB;
constexpr size_t WS_WBQ = 20 * MiB;
constexpr size_t WS_WBOUT = 24 * MiB;
constexpr size_t WS_WMEMKV = 28 * MiB;
constexpr size_t WS_WUP = 32 * MiB;
constexpr size_t WS_WDOWN = 76 * MiB;
constexpr size_t WS_XB = 98 * MiB;
constexpr size_t WS_KB = 162 * MiB;
constexpr size_t WS_VT = 178 * MiB;
constexpr size_t WS_H = 194 * MiB;
constexpr size_t WS_V = WS_H;
constexpr size_t WS_BG = WS_H + 48 * MiB;
constexpr size_t WS_QM = WS_H + 96 * MiB;
constexpr size_t WS_Y = WS_H + 112 * MiB;
constexpr size_t WS_Q = WS_H;
constexpr size_t WS_CTL = 370 * MiB, CTL_BYTES = 65536;
constexpr size_t WS_END = 371 * MiB;

constexpr int LDS_BYTES = 147456;
#define LAS __attribute__((address_space(3)))
typedef unsigned short bf16;
typedef unsigned v4u __attribute__((ext_vector_type(4)));
typedef unsigned v2u __attribute__((ext_vector_type(2)));
typedef float f32x4 __attribute__((ext_vector_type(4)));
typedef float f32x16 __attribute__((ext_vector_type(16)));
typedef short bf16x8 __attribute__((ext_vector_type(8)));
typedef short s16x4 __attribute__((ext_vector_type(4)));
#define LDS_WAIT() asm volatile("s_waitcnt lgkmcnt(0)" ::: "memory")
__device__ __forceinline__ unsigned f2bf(float f) { unsigned u = __builtin_bit_cast(unsigned, f); return (u + 0x7fffu + ((u >> 16) & 1u)) >> 16; }
__device__ __forceinline__ unsigned pk2(float lo, float hi) { return pg8::cvt_pk_bf16(lo, hi); }
__device__ __forceinline__ float bflo(unsigned u) { return __builtin_bit_cast(float, u << 16); }
__device__ __forceinline__ float bfhi(unsigned u) { return __builtin_bit_cast(float, u & 0xffff0000u); }
__device__ __forceinline__ float wave_sum(float v) {
#pragma unroll
    for (int o = 1; o < 64; o <<= 1) v += __shfl_xor(v, o);
    return v;
}

struct Args { const float* in[19]; float* out; unsigned char* ws; };
typedef const Args __attribute__((address_space(4)))* CArgsP;
__device__ __forceinline__ CArgsP kargs() { CArgsP p = (CArgsP)__builtin_amdgcn_kernarg_segment_ptr(); asm volatile("" : "+s"(p)); return p; }
enum { I_X = 0, I_MEM, I_NORM_MIX, I_NORM_FFN, I_A_W_IN, I_A_CONV_W, I_A_W_OUT, I_KV_NORM, I_W_KV, I_B_W_Q, I_B_SINKS, I_B_W_OUT, I_REL_BIAS, I_MEM_NORM, I_W_MEM_KV, I_W_GATE, I_W_UP, I_W_DOWN, I_FINAL_NORM };

template <bool HAS_GAIN>
__device__ __forceinline__ void transpose_item(const float* W, int K, int Nsrc, const float* gain, bf16* WT, int dst_row0, int k0, int n0, LAS float* scr, int lane) {
    const int c = lane & 7;
    f32x4 g0 = {1.f, 1.f, 1.f, 1.f}, g1 = {1.f, 1.f, 1.f, 1.f};
    if (HAS_GAIN) { g0 = *(const f32x4*)(gain + k0 + 8 * c); g1 = *(const f32x4*)(gain + k0 + 8 * c + 4); }
#pragma unroll
    for (int i = 0; i < 32; ++i) { const int kk = 2 * i + (lane >> 5); scr[kk * 33 + (lane & 31)] = W[(size_t)(k0 + kk) * Nsrc + n0 + (lane & 31)]; }
    LDS_WAIT(); asm volatile("" ::: "memory");
#pragma unroll
    for (int j = 0; j < 4; ++j) { const int n = (lane >> 3) + 8 * j; const LAS float* s = scr + (8 * c) * 33 + n;
        v4u o; o.x = pk2(s[0 * 33] * g0[0], s[1 * 33] * g0[1]); o.y = pk2(s[2 * 33] * g0[2], s[3 * 33] * g0[3]); o.z = pk2(s[4 * 33] * g1[0], s[5 * 33] * g1[1]); o.w = pk2(s[6 * 33] * g1[2], s[7 * 33] * g1[3]);
        *(v4u*)(WT + (size_t)(dst_row0 + n) * K + k0 + 8 * c) = o; }
    LDS_WAIT(); asm volatile("" ::: "memory");
}
__device__ __forceinline__ void prologue(LAS unsigned char* lds, int gw, int NGW, int wave, int lane) {
    const CArgsP ka = kargs(); unsigned char* ws = ka->ws;
    LAS float* scr = (LAS float*)(lds + wave * 16384);
    constexpr int N_AIN = 16 * 80, N_SQ = 16 * 32, N_KV = 16 * 16, N_FF = 16 * 88, N_DN = 44 * 32;
    constexpr int NITEMS = 2 * N_AIN + 2 * N_SQ + N_KV + 2 * N_SQ + 2 * N_SQ + 4 * N_KV + 4 * N_FF + 4 * N_FF + 4 * N_DN;
    for (int it = gw; it < NITEMS; it += NGW) {
        int r = it;
        if (r < 2 * N_AIN) { const int l = r / N_AIN; r %= N_AIN; const int kb = r / 80, nb = r % 80, n0 = 32 * nb;
            int dst; if (n0 < 768) dst = 256 * (n0 / 128) + (n0 % 128); else if (n0 < 1536) dst = 1536 + (n0 - 768); else if (n0 < 2304) dst = 256 * ((n0 - 1536) / 128) + 128 + ((n0 - 1536) % 128); else dst = n0;
            transpose_item<true>(ka->in[I_A_W_IN] + (size_t)l * D * APROJ, D, APROJ, ka->in[I_NORM_MIX] + l * D, (bf16*)(ws + WS_WAIN) + (size_t)l * APROJ * D, dst, 64 * kb, n0, scr, lane); continue; }
        r -= 2 * N_AIN;
        if (r < 2 * N_SQ) { const int l = r / N_SQ; r %= N_SQ; const int kb = r / 32, nb = r % 32;
            transpose_item<false>(ka->in[I_A_W_OUT] + (size_t)l * D * D, D, D, nullptr, (bf16*)(ws + WS_WAOUT) + (size_t)l * D * D, 32 * nb, 64 * kb, 32 * nb, scr, lane); continue; }
        r -= 2 * N_SQ;
        if (r < N_KV) { const int kb = r / 16, nb = r % 16;
            transpose_item<true>(ka->in[I_W_KV], D, 512, ka->in[I_KV_NORM], (bf16*)(ws + WS_WKV), (nb < 8 ? 256 + 32 * nb : 32 * (nb - 8)), 64 * kb, 32 * nb, scr, lane); continue; }
        r -= N_KV;
        if (r < 2 * N_SQ) { const int l = r / N_SQ; r %= N_SQ; const int kb = r / 32, nb = r % 32;
            transpose_item<true>(ka->in[I_B_W_Q] + (size_t)l * D * D, D, D, ka->in[I_NORM_MIX] + (2 + l) * D, (bf16*)(ws + WS_WBQ) + (size_t)l * D * D, 32 * nb, 64 * kb, 32 * nb, scr, lane); continue; }
        r -= 2 * N_SQ;
        if (r < 2 * N_SQ) { const int l = r / N_SQ; r %= N_SQ; const int kb = r / 32, nb = r % 32;
            transpose_item<false>(ka->in[I_B_W_OUT] + (size_t)l * D * D, D, D, nullptr, (bf16*)(ws + WS_WBOUT) + (size_t)l * D * D, 32 * nb, 64 * kb, 32 * nb, scr, lane); continue; }
        r -= 2 * N_SQ;
        if (r < 4 * N_KV) { const int l = r / N_KV; r %= N_KV; const int kb = r / 16, nb = r % 16;
            transpose_item<false>(ka->in[I_W_MEM_KV] + (size_t)l * D * 512, D, 512, nullptr, (bf16*)(ws + WS_WMEMKV), (nb < 8 ? 256 * l + 32 * nb : 1024 + 256 * l + 32 * (nb - 8)), 64 * kb, 32 * nb, scr, lane); continue; }
        r -= 4 * N_KV;
        if (r < 8 * N_FF) { const int which = r / (4 * N_FF); r %= 4 * N_FF; const int l = r / N_FF; r %= N_FF; const int kb = r / 88, nb = r % 88, n0 = 32 * nb;
            const int dst = 256 * (n0 / 128) + 128 * which + (n0 % 128);
            transpose_item<true>((which ? ka->in[I_W_UP] : ka->in[I_W_GATE]) + (size_t)l * D * DFF, D, DFF, ka->in[I_NORM_FFN] + l * D, (bf16*)(ws + WS_WUP) + (size_t)l * 2 * DFF * D, dst, 64 * kb, n0, scr, lane); continue; }
        r -= 8 * N_FF;
        { const int l = r / N_DN; r %= N_DN; const int kb = r / 32, nb = r % 32;
            transpose_item<false>(ka->in[I_W_DOWN] + (size_t)l * DFF * D, DFF, D, nullptr, (bf16*)(ws + WS_WDOWN) + (size_t)l * D * DFF, 32 * nb, 64 * kb, 32 * nb, scr, lane); }
    }
    const float* x = ka->in[I_X]; bf16* XB = (bf16*)(ws + WS_XB); float* ssqp = (float*)(ws + WS_SSQ);
    for (int m0 = gw; m0 < M; m0 += 4 * NGW) {
        f32x4 v[4][4];
#pragma unroll
        for (int q = 0; q < 4; ++q) { const f32x4* xr = (const f32x4*)(x + (size_t)(m0 + q * NGW) * D) + lane;
#pragma unroll
            for (int j = 0; j < 4; ++j) v[q][j] = xr[64 * j]; }
#pragma unroll
        for (int q = 0; q < 4; ++q) { const int m = m0 + q * NGW; float s = 0.f;
#pragma unroll
            for (int j = 0; j < 4; ++j) s += (v[q][j].x * v[q][j].x + v[q][j].y * v[q][j].y) + (v[q][j].z * v[q][j].z + v[q][j].w * v[q][j].w);
            s = wave_sum(s);
            unsigned long long* o8 = (unsigned long long*)(XB + (size_t)m * D) + lane;
#pragma unroll
            for (int j = 0; j < 4; ++j) o8[64 * j] = (unsigned long long)pk2(v[q][j].x, v[q][j].y) | ((unsigned long long)pk2(v[q][j].z, v[q][j].w) << 32);
            if (lane < 16) ssqp[(size_t)m * 16 + lane] = lane == 0 ? s : 0.f; }
    }
    const float* mem = ka->in[I_MEM]; const float* mg = ka->in[I_MEM_NORM]; bf16* MEMN = (bf16*)(ws + WS_MEMN);
    for (int m = gw; m < BATCH * NMEM; m += NGW) {
        const f32x4* xr = (const f32x4*)(mem + (size_t)m * D) + lane; const f32x4* gr = (const f32x4*)mg + lane; f32x4 v[4]; float s = 0.f;
#pragma unroll
        for (int j = 0; j < 4; ++j) { v[j] = xr[64 * j]; s += (v[j].x * v[j].x + v[j].y * v[j].y) + (v[j].z * v[j].z + v[j].w * v[j].w); }
        const float rstd = 1.0f / sqrtf(wave_sum(s) * (1.0f / D) + EPS);
        unsigned long long* o8 = (unsigned long long*)(MEMN + (size_t)m * D) + lane;
#pragma unroll
        for (int j = 0; j < 4; ++j) { const f32x4 g = gr[64 * j]; const f32x4 y = v[j] * rstd * g; o8[64 * j] = (unsigned long long)pk2(y.x, y.y) | ((unsigned long long)pk2(y.z, y.w) << 32); }
    }
}

__device__ __forceinline__ unsigned cvtpk(float lo, float hi) { return pg8::cvt_pk_bf16(lo, hi); }
__device__ __forceinline__ void softmax_block(f32x16& S, float& m, float& l, f32x16& o0, f32x16& o1, bf16x8& p0, bf16x8& p1) {
    float bm = fmaxf(S[0], S[1]);
#pragma unroll
    for (int i = 2; i < 16; ++i) bm = fmaxf(bm, S[i]);
    bm = fmaxf(bm, __shfl_xor(bm, 32));
    const float mn = fmaxf(m, bm);
    const float alpha = __builtin_amdgcn_exp2f(m - mn);
    m = mn;
    float sum = 0.f;
#pragma unroll
    for (int i = 0; i < 16; ++i) { S[i] = __builtin_amdgcn_exp2f(S[i] - mn); sum += S[i]; }
    l = l * alpha + sum;
#pragma unroll
    for (int i = 0; i < 16; ++i) { o0[i] *= alpha; o1[i] *= alpha; }
    v4u w0, w1;
    w0.x = cvtpk(S[0], S[1]); w0.y = cvtpk(S[2], S[3]); w0.z = cvtpk(S[4], S[5]); w0.w = cvtpk(S[6], S[7]);
    w1.x = cvtpk(S[8], S[9]); w1.y = cvtpk(S[10], S[11]); w1.z = cvtpk(S[12], S[13]); w1.w = cvtpk(S[14], S[15]);
    p0 = __builtin_bit_cast(bf16x8, w0); p1 = __builtin_bit_cast(bf16x8, w1);
}
__device__ __forceinline__ void attn_store(const f32x16& o0, const f32x16& o1, float l, bf16* yrow, int hi) {
    l += __shfl_xor(l, 32);
    const float inv = 1.0f / l;
#pragma unroll
    for (int g = 0; g < 4; ++g) {
        v2u w; w.x = pk2(o0[4 * g] * inv, o0[4 * g + 1] * inv); w.y = pk2(o0[4 * g + 2] * inv, o0[4 * g + 3] * inv); *(v2u*)(yrow + 8 * g + 4 * hi) = w;
        v2u z; z.x = pk2(o1[4 * g] * inv, o1[4 * g + 1] * inv); z.y = pk2(o1[4 * g + 2] * inv, o1[4 * g + 3] * inv); *(v2u*)(yrow + 32 + 8 * g + 4 * hi) = z;
    }
}
constexpr int KIMG_STRIDE = 144, VIMG_STRIDE = 528, KIMG_BYTES = 256 * KIMG_STRIDE, VIMG_BYTES = 64 * VIMG_STRIDE, TAB_OFF = KIMG_BYTES + VIMG_BYTES;
__device__ __forceinline__ void mem_stage(LAS unsigned char* lds, const bf16* MK, const bf16* MVT, int layer, int b, int h, int tid) {
    const bf16* ksrc = MK + ((size_t)layer * 512 + b * 256) * 256 + h * 64;
    for (int i = tid; i < 256 * 8; i += NTHREADS) { const int key = i >> 3, c = i & 7; *(LAS v4u*)(lds + key * KIMG_STRIDE + c * 16) = *(const v4u*)(ksrc + (size_t)key * 256 + c * 8); }
    const bf16* vsrc = MVT + ((size_t)(layer * 2 + b) * 256 + h * 64) * 256;
    for (int i = tid; i < 64 * 32; i += NTHREADS) { const int d = i >> 5, c = i & 31; *(LAS v4u*)(lds + KIMG_BYTES + d * VIMG_STRIDE + c * 16) = *(const v4u*)(vsrc + (size_t)d * 256 + c * 8); }
    __syncthreads();
}
__device__ __forceinline__ void mem_attn_unit(LAS unsigned char* lds, const bf16* q, int ldq, bf16* y, int ldy, int lane) {
    const int r = lane & 31, hi = lane >> 5;
    bf16x8 qf[4];
#pragma unroll
    for (int s = 0; s < 4; ++s) qf[s] = *(const bf16x8*)(q + (size_t)r * ldq + 16 * s + 8 * hi);
    float m = -1e30f, l = 0.f; f32x16 o0 = {}, o1 = {};
    for (int kb = 0; kb < 8; ++kb) {
        f32x16 S = {};
#pragma unroll
        for (int s = 0; s < 4; ++s) { const bf16x8 kf = *(const LAS bf16x8*)(lds + (kb * 32 + r) * KIMG_STRIDE + (16 * s + 8 * hi) * 2); S = __builtin_amdgcn_mfma_f32_32x32x16_bf16(kf, qf[s], S, 0, 0, 0); }
        bf16x8 p0, p1; softmax_block(S, m, l, o0, o1, p0, p1);
#pragma unroll
        for (int s = 0; s < 2; ++s) {
            const bf16x8 pb = s ? p1 : p0;
#pragma unroll
            for (int db = 0; db < 2; ++db) {
                const LAS unsigned char* vp = lds + KIMG_BYTES + (db * 32 + r) * VIMG_STRIDE + (kb * 32 + 16 * s + 4 * hi) * 2;
                const s16x4 a = *(const LAS s16x4*)vp, c = *(const LAS s16x4*)(vp + 16);
                const bf16x8 vf = (bf16x8){a[0], a[1], a[2], a[3], c[0], c[1], c[2], c[3]};
                if (db == 0) o0 = __builtin_amdgcn_mfma_f32_32x32x16_bf16(vf, pb, o0, 0, 0, 0); else o1 = __builtin_amdgcn_mfma_f32_32x32x16_bf16(vf, pb, o1, 0, 0, 0);
            }
        }
    }
    attn_store(o0, o1, l, y + (size_t)r * ldy, hi);
}
__device__ __forceinline__ void mem_attn_phase(LAS unsigned char* lds, const bf16* MK, const bf16* MVT, int layer, const bf16* Q, int ldq, int qcol0, bf16* Y, int tid, int wave, int lane) {
    const int G = gridDim.x, bh = blockIdx.x & 7, b = bh >> 2, h = bh & 3, slot = blockIdx.x >> 3, nslots = (G - bh + 7) >> 3;
    mem_stage(lds, MK, MVT, layer, b, h, tid);
    for (int g = slot * NWAVES + wave; g < SEQ / 32; g += nslots * NWAVES) {
        const size_t row0 = (size_t)b * SEQ + (size_t)g * 32;
        mem_attn_unit(lds, Q + row0 * ldq + qcol0 + h * 64, ldq, Y + row0 * D + CONVW + h * 64, D, lane);
    }
    __syncthreads();
}

__device__ __forceinline__ void conv_phase(const bf16* V, const bf16* BG, const float* cw, bf16* Y, int gtid, int nthreads) {
    constexpr int NCH = CONVW / 8;
    for (int idx = gtid; idx < (M / 4) * NCH; idx += nthreads) {
        const int rg = idx / NCH, ch = idx % NCH, c0 = ch * 8, t0 = rg * 4, tl = t0 % SEQ;
        float w0[8], w1[8], w2[8];
#pragma unroll
        for (int j = 0; j < 8; j += 4) { const f32x4 a = *(const f32x4*)(cw + c0 + j), b = *(const f32x4*)(cw + CONVW + c0 + j), c = *(const f32x4*)(cw + 2 * CONVW + c0 + j);
#pragma unroll
            for (int e = 0; e < 4; ++e) { w0[j + e] = a[e]; w1[j + e] = b[e]; w2[j + e] = c[e]; } }
        float vm2[8], vm1[8];
        if (tl != 0) { const v4u a = *(const v4u*)(V + (size_t)(t0 - 2) * CONVW + c0), b = *(const v4u*)(V + (size_t)(t0 - 1) * CONVW + c0);
#pragma unroll
            for (int e = 0; e < 4; ++e) { vm2[2 * e] = bflo(a[e]); vm2[2 * e + 1] = bfhi(a[e]); vm1[2 * e] = bflo(b[e]); vm1[2 * e + 1] = bfhi(b[e]); } }
        else {
#pragma unroll
            for (int e = 0; e < 8; ++e) { vm2[e] = 0.f; vm1[e] = 0.f; } }
#pragma unroll
        for (int rr = 0; rr < 4; ++rr) {
            const v4u vv = *(const v4u*)(V + (size_t)(t0 + rr) * CONVW + c0), gg = *(const v4u*)(BG + (size_t)(t0 + rr) * CONVW + c0);
            float v[8], g[8], yv[8];
#pragma unroll
            for (int e = 0; e < 4; ++e) { v[2 * e] = bflo(vv[e]); v[2 * e + 1] = bfhi(vv[e]); g[2 * e] = bflo(gg[e]); g[2 * e + 1] = bfhi(gg[e]); }
#pragma unroll
            for (int e = 0; e < 8; ++e) { yv[e] = g[e] * (w0[e] * vm2[e] + w1[e] * vm1[e] + w2[e] * v[e]); vm2[e] = vm1[e]; vm1[e] = v[e]; }
            v4u o; o.x = pk2(yv[0], yv[1]); o.y = pk2(yv[2], yv[3]); o.z = pk2(yv[4], yv[5]); o.w = pk2(yv[6], yv[7]);
            *(v4u*)(Y + (size_t)(t0 + rr) * D + c0) = o;
        }
    }
}

constexpr int SK_STRIDE = 144, SK_BYTES = 384 * SK_STRIDE, SV_STRIDE = 776, SV_BYTES = 64 * SV_STRIDE, STAB_OFF = SK_BYTES + SV_BYTES;
static_assert(STAB_OFF + 12 * 128 * 4 <= 131072, "swa LDS map");
__device__ __forceinline__ void swa_unit(LAS unsigned char* lds, const LAS float* tab, const bf16* Q, bf16* Y, size_t row0, int tl0, int w, int qh, float sink2, int lane) {
    const int r = lane & 31, hi = lane >> 5;
    bf16x8 qf[4];
#pragma unroll
    for (int s = 0; s < 4; ++s) qf[s] = *(const bf16x8*)(Q + (row0 + r) * D + qh * 64 + 16 * s + 8 * hi);
    float m = sink2, l = hi == 0 ? 1.0f : 0.0f; f32x16 o0 = {}, o1 = {};
    const LAS float* tb = tab + qh * 128;
    const int kb0 = tl0 >= 128 ? 0 : (128 - tl0) >> 5;
    for (int kb = kb0; kb < 5; ++kb) {
        const int j0 = 32 * w + 32 * kb;
        f32x16 S = {};
#pragma unroll
        for (int s = 0; s < 4; ++s) { const bf16x8 kf = *(const LAS bf16x8*)(lds + (j0 + r) * SK_STRIDE + (16 * s + 8 * hi) * 2); S = __builtin_amdgcn_mfma_f32_32x32x16_bf16(kf, qf[s], S, 0, 0, 0); }
#pragma unroll
        for (int i = 0; i < 16; ++i) { const int krow = (i & 3) + 8 * (i >> 2) + 4 * hi; const int dist = 128 - 32 * kb + r - krow;
            S[i] = ((unsigned)dist < 128u) ? S[i] + tb[dist & 127] : -1e30f; }
        bf16x8 p0, p1; softmax_block(S, m, l, o0, o1, p0, p1);
#pragma unroll
        for (int s = 0; s < 2; ++s) {
            const bf16x8 pb = s ? p1 : p0;
#pragma unroll
            for (int db = 0; db < 2; ++db) {
                const LAS unsigned char* vp = lds + SK_BYTES + (db * 32 + r) * SV_STRIDE + (j0 + 16 * s + 4 * hi) * 2;
                const s16x4 a = *(const LAS s16x4*)vp, c = *(const LAS s16x4*)(vp + 16);
                const bf16x8 vf = (bf16x8){a[0], a[1], a[2], a[3], c[0], c[1], c[2], c[3]};
                if (db == 0) o0 = __builtin_amdgcn_mfma_f32_32x32x16_bf16(vf, pb, o0, 0, 0, 0); else o1 = __builtin_amdgcn_mfma_f32_32x32x16_bf16(vf, pb, o1, 0, 0, 0);
            }
        }
    }
    attn_store(o0, o1, l, Y + (row0 + r) * D + qh * 64, hi);
}
__device__ __forceinline__ void swa_phase(LAS unsigned char* lds, const float* rel_bias, const float* sinks, const bf16* Q, const bf16* KB, const bf16* VT, bf16* Y, int tid, int wave, int lane) {
    LAS float* tab = (LAS float*)(lds + STAB_OFF);
    for (int i = tid; i < 12 * 128; i += NTHREADS) { const int h = i >> 7, d = i & 127;
        int bucket = d; if (d >= 16) { bucket = 16 + (int)(log2f((float)d * (1.0f / 16.0f)) * (16.0f / 3.0f)); bucket = bucket > 31 ? 31 : bucket; }
        tab[i] = rel_bias[bucket * 12 + h] * LOG2E; }
    const int G = gridDim.x;
    for (int task = blockIdx.x; task < 4 * (M / 256); task += G) {
        const int kvh = task & 3, chunk = task >> 2, b = chunk / (SEQ / 256), tlc = (chunk % (SEQ / 256)) * 256;
        __syncthreads();
        const int jlo = tlc == 0 ? 128 : 0;
        const bf16* ksrc = KB + ((size_t)b * SEQ + tlc - 128) * 256 + kvh * 64;
        for (int i = tid; i < 384 * 8; i += NTHREADS) { const int j = i >> 3, c = i & 7; if (j >= jlo) *(LAS v4u*)(lds + j * SK_STRIDE + c * 16) = *(const v4u*)(ksrc + (size_t)j * 256 + c * 8); }
        const bf16* vsrc = VT + (size_t)(kvh * 64) * M + (size_t)b * SEQ + tlc - 128;
        for (int i = tid; i < 64 * 96; i += NTHREADS) { const int d = i / 96, c = i % 96; if (c * 4 >= jlo) *(LAS v2u*)(lds + SK_BYTES + d * SV_STRIDE + c * 8) = *(const v2u*)(vsrc + (size_t)d * M + c * 4); }
        __syncthreads();
        const int tl0 = tlc + wave * 32; const size_t row0 = (size_t)b * SEQ + tl0;
        for (int g = 0; g < 3; ++g) { const int qh = kvh * 3 + g; swa_unit(lds, tab, Q, Y, row0, tl0, wave, qh, sinks[qh] * LOG2E, lane); }
    }
    __syncthreads();
}

__device__ __forceinline__ void final_phase(const bf16* XBs, float* out, const float* g, int gw, int NGW, int lane) {
    const f32x4* gr = (const f32x4*)g + lane;
    for (int m0 = gw; m0 < M; m0 += 4 * NGW) {
        v2u v[4][4];
#pragma unroll
        for (int q = 0; q < 4; ++q) { const v2u* xr = (const v2u*)(XBs + (size_t)(m0 + q * NGW) * D) + lane;
#pragma unroll
            for (int j = 0; j < 4; ++j) v[q][j] = xr[64 * j]; }
#pragma unroll
        for (int q = 0; q < 4; ++q) { f32x4* orow = (f32x4*)(out + (size_t)(m0 + q * NGW) * D) + lane; f32x4 f[4]; float s = 0.f;
#pragma unroll
            for (int j = 0; j < 4; ++j) { f[j] = (f32x4){bflo(v[q][j].x), bfhi(v[q][j].x), bflo(v[q][j].y), bfhi(v[q][j].y)}; s += (f[j].x * f[j].x + f[j].y * f[j].y) + (f[j].z * f[j].z + f[j].w * f[j].w); }
            const float rstd = 1.0f / sqrtf(wave_sum(s) * (1.0f / D) + EPS);
#pragma unroll
            for (int j = 0; j < 4; ++j) __builtin_nontemporal_store(f[j] * rstd * gr[64 * j], orow + 64 * j); }
    }
}

#define XB_TMO      128
#define XB_XCNT(j)  (256  + 64 * (j))
#define XB_XSUB(j)  (1280 + 64 * (j))
#define XB_XGEN(j)  (2304 + 64 * (j))
#define XB_TOP      3328
#define XB_TOPGEN   3392
#define XCD_BAR_WORDS 3456
#define XB_SPIN_CAP (1u << 18)

__device__ __forceinline__ unsigned xb_ld(unsigned* p)              { return __hip_atomic_load(p, __ATOMIC_RELAXED, __HIP_MEMORY_SCOPE_AGENT); }
__device__ __forceinline__ unsigned xb_add(unsigned* p, unsigned v) { return __hip_atomic_fetch_add(p, v, __ATOMIC_RELAXED, __HIP_MEMORY_SCOPE_AGENT); }
__device__ __forceinline__ unsigned xb_xcc_id() { return (unsigned)__builtin_amdgcn_s_getreg((3 << 11) | 20) & 0xFu; }
#define XB_SPIN(cond, bar) do { unsigned _sp = 0; while (cond) { __builtin_amdgcn_s_sleep(1); \
    if ((++_sp & 255u) == 0u) { if (xb_ld(&(bar)[XB_TMO])) break; if (_sp > XB_SPIN_CAP) { atomicAdd(&(bar)[XB_TMO], 1u); break; } } } } while (0)

struct XcdBarrier {
    unsigned* bar; unsigned x;
    volatile LAS unsigned* st;
};

__device__ __forceinline__ XcdBarrier xcd_barrier_post(unsigned* bar, volatile LAS unsigned* st) {
    XcdBarrier b; b.bar = bar; b.x = xb_xcc_id(); b.st = st;
    if (threadIdx.x == 0) (void)xb_add(&bar[XB_XCNT(b.x)], 1u);
    return b;
}
__device__ __forceinline__ void xcd_barrier_complete(unsigned* bar, unsigned x, unsigned& nloc, unsigned& nx) {
    const unsigned G = gridDim.x * gridDim.y * gridDim.z;
    unsigned sum, cnt, mine, sp = 0u;
    for (;;) {
        sum = 0u; cnt = 0u; mine = 0u;
#pragma unroll
        for (unsigned j = 0; j < 16; ++j) { const unsigned c = xb_ld(&bar[XB_XCNT(j)]); sum += c; cnt += (c > 0u) ? 1u : 0u; mine = (j == x) ? c : mine; }
        if (sum == G) break;
        __builtin_amdgcn_s_sleep(1);
        if ((++sp & 255u) == 0u) { if (xb_ld(&bar[XB_TMO])) break; if (sp > XB_SPIN_CAP) { atomicAdd(&bar[XB_TMO], 1u); break; } }
    }
    nloc = mine > 0u ? mine : 1u; nx = cnt > 0u ? cnt : 1u;
}

__device__ __forceinline__ void xcd_barrier(const XcdBarrier& b) {
    asm volatile("s_waitcnt vmcnt(0)" ::: "memory");
    __syncthreads();
    if (threadIdx.x == 0) {
        unsigned* bar = b.bar;
        __builtin_amdgcn_s_waitcnt(0);
        unsigned nloc = b.st[0], nx = b.st[1];
        if (nloc == 0u) { xcd_barrier_complete(bar, b.x, nloc, nx); b.st[0] = nloc; b.st[1] = nx; }
        const unsigned old = xb_add(&bar[XB_XSUB(b.x)], 1u);
        const unsigned gen = old / nloc;
        if (old + 1u == (gen + 1u) * nloc) {
            __builtin_amdgcn_fence(__ATOMIC_RELEASE, "agent");
            asm volatile("s_waitcnt vmcnt(0)" ::: "memory");
            const unsigned og = xb_add(&bar[XB_TOP], 1u);
            const unsigned tg = og / nx;
            if (og + 1u == (tg + 1u) * nx) xb_add(&bar[XB_TOPGEN], 1u);
            else XB_SPIN(xb_ld(&bar[XB_TOPGEN]) == tg, bar);
            __builtin_amdgcn_fence(__ATOMIC_ACQUIRE, "agent");
            xb_add(&bar[XB_XGEN(b.x)], 1u);
            asm volatile("s_waitcnt vmcnt(0)" ::: "memory");
        } else {
            XB_SPIN(xb_ld(&bar[XB_XGEN(b.x)]) == gen, bar);
            __builtin_amdgcn_fence(__ATOMIC_ACQUIRE, "agent");
            asm volatile("s_waitcnt vmcnt(0)" ::: "memory");
        }
    }
    __syncthreads();
}

#define GRID_SYNC() do { XcdBarrier b_; b_.bar = (unsigned*)(kargs()->ws + WS_CTL); b_.x = xb_xcc_id(); b_.st = (volatile LAS unsigned*)(lds + 131072) + 8; xcd_barrier(b_); } while (0)
enum StepType { ST_AIN = 0, ST_MIXA, ST_RES, ST_UP, ST_KVQ, ST_ATTB, ST_FINAL };
__global__ void __launch_bounds__(NTHREADS, 2) yoco_fwd(Args a) {
    extern __shared__ __attribute__((aligned(16))) unsigned char lds_raw[];
    cg::grid_group grid = cg::this_grid();
    LAS unsigned char* lds = (LAS unsigned char*)lds_raw;
    const int tid = threadIdx.x, lane = tid & 63, wave = __builtin_amdgcn_readfirstlane(tid >> 6), G = gridDim.x;
    const int gw = blockIdx.x * NWAVES + wave, NGW = G * NWAVES;
    { unsigned char* ws = kargs()->ws;

    volatile LAS unsigned* MISC = (volatile LAS unsigned*)(lds + 131072);
    if (tid < 64) MISC[tid] = 0u;
    __syncthreads();
    (void)xcd_barrier_post((unsigned*)(ws + WS_CTL), MISC + 8);

    prologue(lds, gw, NGW, wave, lane);
    GRID_SYNC(); }

    for (int step = 0; step < 21; ++step) {
        int type, layer, sub = 0;
        if (step < 20) { layer = step / 5; const int k = step % 5; sub = (k == 4);
            type = (k == 0) ? (layer < 2 ? ST_AIN : ST_KVQ) : (k == 1) ? (layer < 2 ? ST_MIXA : ST_ATTB) : (k == 3) ? ST_UP : ST_RES; }
        else { type = ST_FINAL; layer = 3; }
        int tidv = threadIdx.x; asm volatile("" : "+v"(tidv));
        const int lanev = tidv & 63, wavev = __builtin_amdgcn_readfirstlane(tidv >> 6);
        const CArgsP ka = kargs(); unsigned char* ws = ka->ws;
        float* ssqp = (float*)(ws + WS_SSQ); bf16* XB = (bf16*)(ws + WS_XB); bf16* Hb = (bf16*)(ws + WS_H); bf16* Yb = (bf16*)(ws + WS_Y); bf16* MK = (bf16*)(ws + WS_MK); bf16* MVT = (bf16*)(ws + WS_MVT);
        switch (type) {
        case ST_AIN: {
            if (layer == 0) {
                { pg8::Gemm g{(const bf16*)(ws + WS_MEMN), (const bf16*)(ws + WS_WMEMKV), 512, 1024, D}; pg8::StaticOrder S; S.init(512, 1024, G, (int)blockIdx.x);
                  pg8::EpiRowScale E{MK, 256, (const LAS float*)nullptr, 1.0f, (size_t)512 * 256, nullptr, 0};
                  pg8::gemm_phase<pg8::EpiRowScale, pg8::StaticOrder, true, true>(lds, g, S, E, tidv); }
                { pg8::Gemm g{(const bf16*)(ws + WS_WMEMKV) + (size_t)1024 * D, (const bf16*)(ws + WS_MEMN), 1024, 512, D}; pg8::StaticOrder S; S.init(1024, 512, G, (int)((blockIdx.x + G - 8) % G));
                  pg8::EpiVT E{MVT, 256, nullptr, (size_t)2 * 65536, (size_t)65536};
                  pg8::gemm_phase<pg8::EpiVT, pg8::StaticOrder, true, true>(lds, g, S, E, tidv); }
            }
            pg8::Gemm g{XB, (const bf16*)(ws + WS_WAIN) + (size_t)layer * APROJ * D, M, APROJ, D}; pg8::StaticOrder S; S.init(M, APROJ, G, (int)blockIdx.x);
            pg8::fill_rstd(lds, ssqp, S, tidv);
            pg8::EpiAIn E{(bf16*)(ws + WS_V), (bf16*)(ws + WS_BG), (bf16*)(ws + WS_QM), (const LAS float*)(lds + pg8::RSTAB_OFF), QSCALE};
            pg8::gemm_phase<pg8::EpiAIn, pg8::StaticOrder, true, true>(lds, g, S, E, tidv);
        } break;
        case ST_MIXA: {
            conv_phase((const bf16*)(ws + WS_V), (const bf16*)(ws + WS_BG), ka->in[I_A_CONV_W] + (size_t)layer * 3 * CONVW, Yb, blockIdx.x * NTHREADS + tidv, G * NTHREADS);
            mem_attn_phase(lds, MK, MVT, layer, (const bf16*)(ws + WS_QM), 256, 0, Yb, tidv, wavev, lanev);
        } break;
        case ST_RES: {
            const bf16* A = sub ? Hb : Yb; const int K = sub ? DFF : D;
            const bf16* Bt = sub ? (const bf16*)(ws + WS_WDOWN) + (size_t)layer * D * DFF : (layer < 2 ? (const bf16*)(ws + WS_WAOUT) + (size_t)layer * D * D : (const bf16*)(ws + WS_WBOUT) + (size_t)(layer - 2) * D * D);
            pg8::Gemm g{A, Bt, M, D, K}; pg8::StaticOrder S; S.init(M, D, G, (int)blockIdx.x);
            pg8::EpiRes E{XB, ssqp};
            pg8::gemm_phase<pg8::EpiRes, pg8::StaticOrder, true, true>(lds, g, S, E, tidv);
        } break;
        case ST_UP: {
            pg8::Gemm g{XB, (const bf16*)(ws + WS_WUP) + (size_t)layer * 2 * DFF * D, M, 2 * DFF, D}; pg8::StaticOrder S; S.init(M, 2 * DFF, G, (int)blockIdx.x);
            pg8::fill_rstd(lds, ssqp, S, tidv);
            pg8::EpiSwiglu E{Hb, (const LAS float*)(lds + pg8::RSTAB_OFF)};
            pg8::gemm_phase<pg8::EpiSwiglu, pg8::StaticOrder, true, true>(lds, g, S, E, tidv);
        } break;
        case ST_KVQ: {
            if (layer == 2) {
                pg8::Gemm g{(const bf16*)(ws + WS_WKV), XB, 256, M, D}; pg8::StaticOrder S; S.init(256, M, G, (int)((blockIdx.x + G - 128) % G));
                pg8::EpiVT E{(bf16*)(ws + WS_VT), M, ssqp, (size_t)0, (size_t)256};
                pg8::gemm_phase<pg8::EpiVT, pg8::StaticOrder, true, true>(lds, g, S, E, tidv);
            }
            const int pn0 = layer == 2 ? 1 : 0;
            pg8::Gemm g{XB, layer == 2 ? (const bf16*)(ws + WS_WKV) + (size_t)256 * D : (const bf16*)(ws + WS_WBQ) + (size_t)D * D, M, D + 256 * pn0, D}; pg8::StaticOrder S; S.init(M, D + 256 * pn0, G, (int)blockIdx.x);
            pg8::fill_rstd(lds, ssqp, S, tidv);
            pg8::EpiRowScale E{(bf16*)(ws + WS_Q), D, (const LAS float*)(lds + pg8::RSTAB_OFF), QSCALE, (size_t)256, (bf16*)(ws + WS_KB), pn0};
            pg8::gemm_phase<pg8::EpiRowScale, pg8::StaticOrder, true, true>(lds, g, S, E, tidv);
        } break;
        case ST_ATTB: {
            swa_phase(lds, ka->in[I_REL_BIAS], ka->in[I_B_SINKS] + (layer - 2) * 12, (const bf16*)(ws + WS_Q), (const bf16*)(ws + WS_KB), (const bf16*)(ws + WS_VT), Yb, tidv, wavev, lanev);
            mem_attn_phase(lds, MK, MVT, layer, (const bf16*)(ws + WS_Q), D, CONVW, Yb, tidv, wavev, lanev);
        } break;
        default: {
            final_phase(XB, ka->out, ka->in[I_FINAL_NORM], blockIdx.x * NWAVES + wavev, NGW, lanev);
        } break;
        }
        if (step < 20) GRID_SYNC();
    }
    if (kargs()->out == nullptr) grid.sync();
}

extern "C" void kernel_launch(void* const* d_in, const int* in_sizes, int n_in, void* d_out, int out_size, void* d_ws, size_t ws_size, hipStream_t stream) {
    static int grid = 0;
    if (grid == 0) {
        if (n_in != 19 || out_size != M * D || ws_size < WS_END) { fprintf(stderr, "kernel_launch: unexpected shapes (n_in %d out %d ws %zu)\n", n_in, out_size, ws_size); grid = -1; return; }
        int dev = 0, cus = 0, per_cu = 0;
        if (hipGetDevice(&dev) != hipSuccess || hipDeviceGetAttribute(&cus, hipDeviceAttributeMultiprocessorCount, dev) != hipSuccess) { grid = -1; return; }
        if (hipFuncSetAttribute((const void*)yoco_fwd, hipFuncAttributeMaxDynamicSharedMemorySize, LDS_BYTES) != hipSuccess) { fprintf(stderr, "kernel_launch: hipFuncSetAttribute failed\n"); grid = -1; return; }
        if (hipOccupancyMaxActiveBlocksPerMultiprocessor(&per_cu, (const void*)yoco_fwd, NTHREADS, LDS_BYTES) != hipSuccess || per_cu < 1) per_cu = 1;
        (void)hipGetLastError();
        grid = cus * per_cu;
        if (grid != 256) { fprintf(stderr, "kernel_launch: built for a 256-workgroup grid (one per CU), got %d\n", grid); grid = -1; return; }
    }
    if (grid < 0) return;
    if (hipMemsetAsync((char*)d_ws + WS_CTL, 0, CTL_BYTES, stream) != hipSuccess) { fprintf(stderr, "kernel_launch: memset failed\n"); return; }
    Args a{};
    for (int i = 0; i < 19; ++i) a.in[i] = (const float*)d_in[i];
    a.out = (float*)d_out; a.ws = (unsigned char*)d_ws;
    void* args[] = {&a};
    const hipError_t e = hipLaunchCooperativeKernel((const void*)yoco_fwd, dim3(grid), dim3(NTHREADS), args, LDS_BYTES, stream);
    if (e != hipSuccess) fprintf(stderr, "kernel_launch: cooperative launch failed: %s (grid %d)\n", hipGetErrorString(e), grid);
}
```

```cpp
#include <hip/hip_runtime.h>
#include <hip/hip_cooperative_groups.h>
#include <cstdio>
#include <cstdint>
namespace cg = cooperative_groups;
namespace pg8 {
#define PG8_LAS __attribute__((address_space(3)))
typedef unsigned short bf16_t;
typedef short bf16x8 __attribute__((ext_vector_type(8)));
typedef float f32x4 __attribute__((ext_vector_type(4)));
typedef unsigned u32x4 __attribute__((ext_vector_type(4)));
constexpr int BM = 256, BK = 64, HALF = 128, HTB = HALF * BK * 2  , STAGE_BYTES = 8 * HTB, NXCD = 8, WGM = 4;

__host__ __device__ __forceinline__ int lds_byte(int r, int c) { const int st = (r >> 4) * 2 + (c >> 5), rr = r & 15, cc = c & 31, ob = rr * 64 + cc * 2; return st * 1024 + (ob ^ (((ob >> 9) & 1) << 5)); }
__host__ __device__ __forceinline__ void stage_rc(int b, int& R, int& C) { const int st = b / 1024, sb = b % 1024, swz = sb ^ (((sb >> 9) & 1) << 5); R = (st >> 1) * 16 + swz / 64; C = (st & 1) * 32 + (swz % 64) / 2; }
__host__ __device__ __forceinline__ int perm32(int rho) { const int n = rho >> 4, i = rho & 15; return 8 * (i >> 2) + 4 * n + (i & 3); }

struct Unit { int pm, pn, ui; };
struct Gemm { const bf16_t* A; const bf16_t* Bt; int M, N, K; };

struct StaticOrder {
    int nM, nN, nwg, G, c;
    __host__ __device__ void init(int M, int N, int G_, int c_) { nM = M / BM; nN = N / BM; nwg = nM * nN; G = G_; c = c_; }
    __host__ __device__ bool next(int i, Unit& u) const {
        const long L = (long)i * G + c; if (L >= nwg) return false;
        int wgid = (int)L; { const int q = nwg / NXCD, r = nwg % NXCD, xcd = wgid % NXCD, off = wgid / NXCD; wgid = (xcd < r ? xcd * (q + 1) : r * (q + 1) + (xcd - r) * q) + off; }
        const int nig = WGM * nN, gid = wgid / nig, fm = gid * WGM, gsz = (nM - fm) < WGM ? (nM - fm) : WGM;
        u.pm = fm + ((wgid % nig) % gsz); u.pn = (wgid % nig) / gsz; u.ui = i; return true;
    }
    __device__ __forceinline__ void a_ready(const Unit&) const {}
    __device__ __forceinline__ void done(const Unit&) const {}
};
typedef float f32x2_t __attribute__((ext_vector_type(2))); typedef __bf16 bf16x2_t __attribute__((ext_vector_type(2)));
__device__ __forceinline__ unsigned cvt_pk_bf16(float lo, float hi) { f32x2_t v = {lo, hi}; bf16x2_t b = __builtin_convertvector(v, bf16x2_t); return __builtin_bit_cast(unsigned, b); }
typedef float f32x2 __attribute__((ext_vector_type(2)));
typedef unsigned u32x2 __attribute__((ext_vector_type(2)));
constexpr int DMODEL = 1024;
__device__ __forceinline__ float row_rstd(const float* ssqp, int row) {
    const f32x4* p = (const f32x4*)(ssqp + (size_t)row * 16);
    const f32x4 a = p[0], b = p[1], c = p[2], d = p[3];
    const f32x4 s = (a + b) + (c + d);
    const float t = (s[0] + s[1]) + (s[2] + s[3]);
    return __builtin_amdgcn_rsqf(t * (1.0f / 1024.0f) + 1e-5f);
}
constexpr int RSTAB_OFF = 132096;
template <class Sched> __device__ __forceinline__ void fill_rstd(PG8_LAS unsigned char* lds, const float* ssqp, const Sched& S, int tid) {
    PG8_LAS float* tab = (PG8_LAS float*)(lds + RSTAB_OFF); Unit u; const int row = tid >> 1, half = tid & 1;
    for (int i = 0; S.next(i, u); ++i) { const f32x4* p = (const f32x4*)(ssqp + (size_t)(u.pm * BM + row) * 16 + half * 8); const f32x4 a = p[0], b = p[1], s4 = a + b; float s = (s4[0] + s4[1]) + (s4[2] + s4[3]);
        s += __shfl_xor(s, 1); if (half == 0) tab[i * 256 + row] = __builtin_amdgcn_rsqf(s * (1.0f / 1024.0f) + 1e-5f); }
    __syncthreads();
}
__device__ __forceinline__ u32x4 pack8(f32x4 v0, f32x4 v1) { u32x4 w; w.x = cvt_pk_bf16(v0[0], v0[1]); w.y = cvt_pk_bf16(v0[2], v0[3]); w.z = cvt_pk_bf16(v1[0], v1[1]); w.w = cvt_pk_bf16(v1[2], v1[3]); return w; }
__device__ __forceinline__ unsigned short f2bf1(float f) { unsigned u = __builtin_bit_cast(unsigned, f); return (unsigned short)((u + 0x7fffu + ((u >> 16) & 1u)) >> 16); }

struct EpiAIn {
    static constexpr bool PERM = true, AFTER_DRAIN = false;
    bf16_t *V, *BG, *QM; const PG8_LAS float* rstab; float qscale;
    __device__ __forceinline__ void operator()(const f32x4 (&acc)[2][2][4][2], const Unit& u, int wr, int wc, int fr, int fq) const {
        const int row0 = u.pm * BM + wr * 64 + fr, cl = wc * 32 + 8 * fq; const PG8_LAS float* rt = rstab + u.ui * 256 + wr * 64 + fr;
        if (u.pn < 6) {
#pragma unroll
            for (int ai = 0; ai < 2; ++ai)
#pragma unroll
                for (int m = 0; m < 4; ++m) { const int row = row0 + ai * HALF + m * 16; const float r = rt[ai * HALF + m * 16], r2 = r * r;
                    *(u32x4*)(V + (size_t)row * 768 + u.pn * 128 + cl) = pack8(acc[ai][0][m][0] * acc[ai][1][m][0] * r2, acc[ai][0][m][1] * acc[ai][1][m][1] * r2); }
        } else if (u.pn < 9) {
#pragma unroll
            for (int ai = 0; ai < 2; ++ai)
#pragma unroll
                for (int m = 0; m < 4; ++m) { const int row = row0 + ai * HALF + m * 16; const float r = rt[ai * HALF + m * 16];
#pragma unroll
                    for (int bj = 0; bj < 2; ++bj) *(u32x4*)(BG + (size_t)row * 768 + (u.pn - 6) * 256 + bj * HALF + cl) = pack8(acc[ai][bj][m][0] * r, acc[ai][bj][m][1] * r); }
        } else {
#pragma unroll
            for (int ai = 0; ai < 2; ++ai)
#pragma unroll
                for (int m = 0; m < 4; ++m) { const int row = row0 + ai * HALF + m * 16; const float r = rt[ai * HALF + m * 16] * qscale;
#pragma unroll
                    for (int bj = 0; bj < 2; ++bj) *(u32x4*)(QM + (size_t)row * 256 + bj * HALF + cl) = pack8(acc[ai][bj][m][0] * r, acc[ai][bj][m][1] * r); }
        }
    }
};
struct EpiRowScale {
    static constexpr bool PERM = true, AFTER_DRAIN = false;
    bf16_t* O; int ldc; const PG8_LAS float* rstab; float scale; size_t pn_stride; bf16_t* KO; int pn0;
    __device__ __forceinline__ void operator()(const f32x4 (&acc)[2][2][4][2], const Unit& u, int wr, int wc, int fr, int fq) const {
        const int row0 = u.pm * BM + wr * 64 + fr, cl = wc * 32 + 8 * fq; const bool isk = u.pn < pn0;
        bf16_t* ob = isk ? KO + cl : O + (size_t)(u.pn - pn0) * pn_stride + cl; const int ld = isk ? 256 : ldc; const float sc = isk ? 1.0f : scale;
        const PG8_LAS float* rt = rstab + u.ui * 256 + wr * 64 + fr;
#pragma unroll
        for (int ai = 0; ai < 2; ++ai)
#pragma unroll
            for (int m = 0; m < 4; ++m) { const int row = row0 + ai * HALF + m * 16; const float r = rstab ? rt[ai * HALF + m * 16] * sc : sc;
#pragma unroll
                for (int bj = 0; bj < 2; ++bj) *(u32x4*)(ob + (size_t)row * ld + bj * HALF) = pack8(acc[ai][bj][m][0] * r, acc[ai][bj][m][1] * r); }
    }
};
struct EpiVT {
    static constexpr bool PERM = true, AFTER_DRAIN = true;
    bf16_t* O; int ld; const float* ssqp; size_t pm_stride, pn_stride;
    __device__ __forceinline__ void fused(f32x4 (&acc)[2][2][4][2], const Unit& u, int wr, int wc, int fr, int fq, PG8_LAS unsigned char* lds, int wid, int lane) const {
        PG8_LAS float* rs = (PG8_LAS float*)lds;
        { const int t = wid * 64 + lane, tok = t >> 1, half = t & 1; float r = 1.0f;
          if (ssqp) { const f32x4* p = (const f32x4*)(ssqp + (size_t)(u.pn * BM + tok) * 16 + half * 8); const f32x4 a = p[0], b = p[1], s4 = a + b; float s = (s4[0] + s4[1]) + (s4[2] + s4[3]);
              s += __shfl_xor(s, 1); r = __builtin_amdgcn_rsqf(s * (1.0f / 1024.0f) + 1e-5f); }
          if (half == 0) rs[tok] = r; }
        asm volatile("s_waitcnt lgkmcnt(0)" ::: "memory"); __builtin_amdgcn_s_barrier(); asm volatile("" ::: "memory");
        const int rl0 = wr * 64 + fr, cl = wc * 32 + 8 * fq; bf16_t* ob = O + (size_t)u.pm * pm_stride + (size_t)u.pn * pn_stride + cl;
#pragma unroll
        for (int bj = 0; bj < 2; ++bj) {
            const f32x4 s0 = *(const PG8_LAS f32x4*)(rs + bj * HALF + cl), s1 = *(const PG8_LAS f32x4*)(rs + bj * HALF + cl + 4);
#pragma unroll
            for (int ai = 0; ai < 2; ++ai)
#pragma unroll
                for (int m = 0; m < 4; ++m) *(u32x4*)(ob + (size_t)(rl0 + ai * HALF + m * 16) * ld + bj * HALF) = pack8(acc[ai][bj][m][0] * s0, acc[ai][bj][m][1] * s1);
        }
        asm volatile("s_waitcnt lgkmcnt(0)" ::: "memory"); __builtin_amdgcn_s_barrier(); asm volatile("" ::: "memory");
    }
};
struct EpiSwiglu {
    static constexpr bool PERM = true, AFTER_DRAIN = false;
    bf16_t* H; const PG8_LAS float* rstab;
    __device__ __forceinline__ void operator()(const f32x4 (&acc)[2][2][4][2], const Unit& u, int wr, int wc, int fr, int fq) const {
        const int row0 = u.pm * BM + wr * 64 + fr, cl = u.pn * 128 + wc * 32 + 8 * fq; const PG8_LAS float* rt = rstab + u.ui * 256 + wr * 64 + fr;
#pragma unroll
        for (int ai = 0; ai < 2; ++ai)
#pragma unroll
            for (int m = 0; m < 4; ++m) { const int row = row0 + ai * HALF + m * 16; const float r = rt[ai * HALF + m * 16], nr = r * -1.4426950408889634f, r2 = r * r;
                f32x4 hv[2];
#pragma unroll
                for (int n = 0; n < 2; ++n) { const f32x4 ag = acc[ai][0][m][n], au = acc[ai][1][m][n]; const f32x4 t = ag * nr, gu = (ag * au) * r2; f32x4 d;
#pragma unroll
                    for (int j = 0; j < 4; ++j) d[j] = __builtin_amdgcn_rcpf(1.0f + __builtin_amdgcn_exp2f(t[j]));
                    hv[n] = gu * d; }
                __builtin_nontemporal_store(pack8(hv[0], hv[1]), (u32x4*)(H + (size_t)row * 2816 + cl)); }
    }
};
struct EpiRes {
    static constexpr bool PERM = true, AFTER_DRAIN = false;
    bf16_t* xb; float* ssqp;
    __device__ __forceinline__ void operator()(const f32x4 (&acc)[2][2][4][2], const Unit& u, int wr, int wc, int fr, int fq) const {
        const int row0 = u.pm * BM + wr * 64 + fr, cl = u.pn * BM + wc * 32 + 8 * fq;
#pragma unroll
        for (int ai = 0; ai < 2; ++ai)
#pragma unroll
            for (int m = 0; m < 4; ++m) { const int row = row0 + ai * HALF + m * 16; bf16_t* xp = xb + (size_t)row * DMODEL + cl; float q = 0.f;
#pragma unroll
                for (int bj = 0; bj < 2; ++bj) { const u32x4 o = *(const u32x4*)(xp + bj * HALF);
                    const f32x4 b0 = {__builtin_bit_cast(float, o.x << 16), __builtin_bit_cast(float, o.x & 0xffff0000u), __builtin_bit_cast(float, o.y << 16), __builtin_bit_cast(float, o.y & 0xffff0000u)};
                    const f32x4 b1 = {__builtin_bit_cast(float, o.z << 16), __builtin_bit_cast(float, o.z & 0xffff0000u), __builtin_bit_cast(float, o.w << 16), __builtin_bit_cast(float, o.w & 0xffff0000u)};
                    const f32x4 x0 = b0 + acc[ai][bj][m][0], x1 = b1 + acc[ai][bj][m][1];
                    *(u32x4*)(xp + bj * HALF) = pack8(x0, x1);
                    q += (x0[0] * x0[0] + x0[1] * x0[1]) + (x0[2] * x0[2] + x0[3] * x0[3]) + (x1[0] * x1[0] + x1[1] * x1[1]) + (x1[2] * x1[2] + x1[3] * x1[3]); }
                q += __shfl_xor(q, 16); q += __shfl_xor(q, 32);
                if (fq == 0) ssqp[(size_t)row * 16 + u.pn * 4 + wc] = q; }
    }
};
template <class Epi, class Sched, bool ALIGN_EPI = false, bool SP2 = false>
__device__ __forceinline__ void gemm_phase(PG8_LAS unsigned char* lds, const Gemm g, const Sched& S, const Epi& E, const int tid) {
    const int wid = __builtin_amdgcn_readfirstlane(tid >> 6), lane = tid & 63, wr = wid >> 2, wc = wid & 3, fr = lane & 15, fq = lane >> 4;
    const int K = g.K, nt = K / BK;
    unsigned voffA[2], voffB[2];
#pragma unroll
    for (int i = 0; i < 2; ++i) { int R, C; stage_rc(tid * 16 + i * 8192, R, C); const int Rb = Epi::PERM ? ((R & ~31) + perm32(R & 31)) : R;
        voffA[i] = (unsigned)(R * K + C) * 2u; voffB[i] = (unsigned)(Rb * K + C) * 2u; }
    const size_t kstep = (size_t)(BK * 2);
    const size_t hstep = (size_t)HALF * K * 2;
    const size_t tstep = 2 * hstep;
    const unsigned ldsw = (unsigned)wid * 1024u;
    const int aoff = lds_byte(wr * 64 + fr, fq * 8), boff = lds_byte(wc * 32 + fr, fq * 8);
#define PG8_SA(b, h) (((b) * 2 + (h)) * HTB)
#define PG8_SB(b, h) ((4 + (b) * 2 + (h)) * HTB)
#define PG8_STAGE(bufoff, gbase, voff) do { _Pragma("unroll") for (int _i = 0; _i < 2; ++_i) \
        __builtin_amdgcn_global_load_lds((const unsigned*)((const char*)(gbase) + (voff)[_i]), (PG8_LAS unsigned*)(lds + (bufoff) + ldsw + _i * 8192), 16, 0, 0); } while (0)
#define PG8_LDA(dst, b, h) do { _Pragma("unroll") for (int m = 0; m < 4; ++m) _Pragma("unroll") for (int k = 0; k < 2; ++k) dst[m][k] = *(const PG8_LAS bf16x8*)(lds + PG8_SA(b, h) + aoff + m * 2048 + k * 1024); } while (0)
#define PG8_LDB(dst, b, h) do { _Pragma("unroll") for (int n = 0; n < 2; ++n) _Pragma("unroll") for (int k = 0; k < 2; ++k) dst[n][k] = *(const PG8_LAS bf16x8*)(lds + PG8_SB(b, h) + boff + n * 2048 + k * 1024); } while (0)
#define PG8_MMA(ai, bj, At, Bt) do { __builtin_amdgcn_s_setprio(1); _Pragma("unroll") for (int m = 0; m < 4; ++m) _Pragma("unroll") for (int n = 0; n < 2; ++n) _Pragma("unroll") for (int k = 0; k < 2; ++k) \
        acc[ai][bj][m][n] = __builtin_amdgcn_mfma_f32_16x16x32_bf16(Bt[n][k], At[m][k], acc[ai][bj][m][n], 0, 0, 0); __builtin_amdgcn_s_setprio(0); } while (0)
#define PG8_WAIT_V(n) asm volatile("s_waitcnt vmcnt(" #n ")" ::: "memory")
#define PG8_WAIT_L(n) asm volatile("s_waitcnt lgkmcnt(" #n ")" ::: "memory")
#define PG8_BAR __builtin_amdgcn_s_barrier()
#define PG8_SCHED __builtin_amdgcn_sched_barrier(0)
    Unit cur, nxt; int ui = 0;
    if (!S.next(0, cur)) return;
    f32x4 acc[2][2][4][2];
#pragma unroll
    for (int a = 0; a < 2; ++a)
#pragma unroll
        for (int b = 0; b < 2; ++b)
#pragma unroll
            for (int m = 0; m < 4; ++m)
#pragma unroll
                for (int n = 0; n < 2; ++n) acc[a][b][m][n] = (f32x4){0.f, 0.f, 0.f, 0.f};
    bf16x8 At[4][2], B0[2][2], B1[2][2];
    const char* cA = (const char*)g.A + (size_t)cur.pm * tstep; const char* cB = (const char*)g.Bt + (size_t)cur.pn * tstep;
    S.a_ready(cur);
    if constexpr (SP2) {
        PG8_STAGE(PG8_SB(0, 0), cB, voffB); PG8_STAGE(PG8_SB(0, 1), cB + hstep, voffB); PG8_STAGE(PG8_SA(0, 0), cA, voffA); PG8_STAGE(PG8_SA(0, 1), cA + hstep, voffA);
        if (wr == 1) PG8_BAR;
        PG8_WAIT_V(2); PG8_BAR;
        PG8_STAGE(PG8_SB(1, 0), cB + kstep, voffB); PG8_STAGE(PG8_SA(1, 0), cA + kstep, voffA); PG8_STAGE(PG8_SB(1, 1), cB + hstep + kstep, voffB);
        PG8_WAIT_V(6); PG8_BAR;
    } else {
        PG8_STAGE(PG8_SB(0, 0), cB, voffB); PG8_STAGE(PG8_SA(0, 0), cA, voffA); PG8_STAGE(PG8_SB(0, 1), cB + hstep, voffB); PG8_STAGE(PG8_SA(0, 1), cA + hstep, voffA);
        if (wr == 1) PG8_BAR;
        PG8_WAIT_V(4); PG8_BAR;
        PG8_STAGE(PG8_SB(1, 0), cB + kstep, voffB); PG8_STAGE(PG8_SA(1, 0), cA + kstep, voffA); PG8_STAGE(PG8_SB(1, 1), cB + hstep + kstep, voffB);
        PG8_WAIT_V(6); PG8_BAR;
    }
    for (;;) {
        const bool has_next = S.next(ui + 1, nxt);
        const char* nA = has_next ? (const char*)g.A + (size_t)nxt.pm * tstep : cA; const char* nB = has_next ? (const char*)g.Bt + (size_t)nxt.pn * tstep : cB;
        for (int t = 0; t < nt; t += 2) {
            const bool last = (t == nt - 2);
            const char* a1 = cA + (size_t)(t + 1) * kstep;
            const char* a2 = last ? nA : cA + (size_t)(t + 2) * kstep; const char* b2 = last ? nB : cB + (size_t)(t + 2) * kstep;
            const char* a3 = a2 + kstep; const char* b3 = b2 + kstep;
            if (last && has_next) S.a_ready(nxt);
            if constexpr (SP2) {
            PG8_LDB(B0, 0, 0); PG8_LDB(B1, 0, 1); PG8_SCHED; PG8_LDA(At, 0, 0); PG8_STAGE(PG8_SA(1, 1), a1 + hstep, voffA);
            PG8_WAIT_V(8); PG8_WAIT_L(0); PG8_BAR; PG8_MMA(0, 0, At, B0); PG8_MMA(0, 1, At, B1); PG8_BAR; PG8_SCHED;
            PG8_LDA(At, 0, 1); PG8_STAGE(PG8_SB(0, 0), b2, voffB); PG8_STAGE(PG8_SB(0, 1), b2 + hstep, voffB); PG8_STAGE(PG8_SA(0, 0), a2, voffA);
            PG8_WAIT_V(8); PG8_WAIT_L(0); PG8_BAR; PG8_MMA(1, 0, At, B0); PG8_MMA(1, 1, At, B1); PG8_BAR; PG8_SCHED;
            PG8_LDB(B0, 1, 0); PG8_LDB(B1, 1, 1); PG8_SCHED; PG8_LDA(At, 1, 0); PG8_STAGE(PG8_SA(0, 1), a2 + hstep, voffA);
            PG8_WAIT_V(8); PG8_WAIT_L(0); PG8_BAR; PG8_MMA(0, 0, At, B0); PG8_MMA(0, 1, At, B1); PG8_BAR; PG8_SCHED;
            PG8_LDA(At, 1, 1); PG8_STAGE(PG8_SB(1, 0), b3, voffB); PG8_STAGE(PG8_SB(1, 1), b3 + hstep, voffB); PG8_STAGE(PG8_SA(1, 0), a3, voffA);
            PG8_WAIT_V(8); PG8_WAIT_L(0); PG8_BAR; PG8_MMA(1, 0, At, B0); PG8_MMA(1, 1, At, B1); PG8_BAR; PG8_SCHED;
            } else {
            PG8_LDB(B0, 0, 0); PG8_SCHED; PG8_LDA(At, 0, 0); PG8_STAGE(PG8_SA(1, 1), a1 + hstep, voffA);
            PG8_WAIT_L(8); PG8_BAR; PG8_WAIT_L(0); PG8_MMA(0, 0, At, B0); PG8_BAR; PG8_SCHED;
            PG8_LDB(B1, 0, 1); PG8_STAGE(PG8_SB(0, 0), b2, voffB);
            PG8_BAR; PG8_WAIT_L(0); PG8_MMA(0, 1, At, B1); PG8_BAR;
            PG8_LDA(At, 0, 1); PG8_STAGE(PG8_SA(0, 0), a2, voffA);
            PG8_BAR; PG8_WAIT_L(0); PG8_MMA(1, 0, At, B0); PG8_BAR; PG8_SCHED;
            PG8_STAGE(PG8_SB(0, 1), b2 + hstep, voffB);
            PG8_WAIT_V(6); PG8_BAR; PG8_MMA(1, 1, At, B1); PG8_BAR;
            PG8_LDB(B0, 1, 0); PG8_SCHED; PG8_LDA(At, 1, 0); PG8_STAGE(PG8_SA(0, 1), a2 + hstep, voffA);
            PG8_WAIT_L(8); PG8_BAR; PG8_WAIT_L(0); PG8_MMA(0, 0, At, B0); PG8_BAR; PG8_SCHED;
            PG8_LDB(B1, 1, 1); PG8_STAGE(PG8_SB(1, 0), b3, voffB);
            PG8_BAR; PG8_WAIT_L(0); PG8_MMA(0, 1, At, B1); PG8_BAR;
            PG8_LDA(At, 1, 1); PG8_STAGE(PG8_SA(1, 0), a3, voffA);
            PG8_BAR; PG8_WAIT_L(0); PG8_MMA(1, 0, At, B0); PG8_BAR; PG8_SCHED;
            PG8_STAGE(PG8_SB(1, 1), b3 + hstep, voffB);
            PG8_WAIT_V(6); PG8_BAR; PG8_MMA(1, 1, At, B1); PG8_BAR;
            }
        }
        if constexpr (ALIGN_EPI) { if (wr == 0) PG8_BAR; }
        if constexpr (!Epi::AFTER_DRAIN) { E(acc, cur, wr, wc, fr, fq); S.done(cur); }
        if (!has_next) break;
#pragma unroll
        for (int a = 0; a < 2; ++a)
#pragma unroll
            for (int b = 0; b < 2; ++b)
#pragma unroll
                for (int m = 0; m < 4; ++m)
#pragma unroll
                    for (int n = 0; n < 2; ++n) acc[a][b][m][n] = (f32x4){0.f, 0.f, 0.f, 0.f};
        cur = nxt; cA = nA; cB = nB; ++ui;
        if constexpr (ALIGN_EPI) { if (wr == 1) PG8_BAR; }
    }
    PG8_WAIT_V(0);
    if constexpr (!ALIGN_EPI) { if (wr == 0) PG8_BAR; }
    PG8_BAR;
    if constexpr (Epi::AFTER_DRAIN) { E.fused(acc, cur, wr, wc, fr, fq, lds, wid, lane); S.done(cur); }
#undef PG8_SA
#undef PG8_SB
#undef PG8_STAGE
#undef PG8_LDA
#undef PG8_LDB
#undef PG8_MMA
#undef PG8_WAIT_V
#undef PG8_WAIT_L
#undef PG8_BAR
#undef PG8_SCHED
}
}

constexpr int BATCH = 2, SEQ = 16384, D = 1024, M = BATCH * SEQ, NMEM = 256, DFF = 2816, CONVW = 768, APROJ = 2560;
constexpr int NWAVES = 8, NTHREADS = 512;
constexpr float LOG2E = 1.4426950408889634f, QSCALE = 0.125f * LOG2E, EPS = 1e-5f;

constexpr size_t MiB = 1u << 20;
constexpr size_t WS_SSQ = 0;
constexpr size_t WS_MEMN = 2 * MiB;
constexpr size_t WS_MK = 3 * MiB;
constexpr size_t WS_MVT = 4 * MiB;
constexpr size_t WS_WAIN = 5 * MiB;
constexpr size_t WS_WAOUT = 15 * MiB;
constexpr size_t WS_WKV = 19 * MiB;
constexpr size_t WS_WBQ = 20 * MiB;
constexpr size_t WS_WBOUT = 24 * MiB;
constexpr size_t WS_WMEMKV = 28 * MiB;
constexpr size_t WS_WUP = 32 * MiB;
constexpr size_t WS_WDOWN = 76 * MiB;
constexpr size_t WS_XB = 98 * MiB;
constexpr size_t WS_KB = 162 * MiB;
constexpr size_t WS_VT = 178 * MiB;
constexpr size_t WS_H = 194 * MiB;
constexpr size_t WS_V = WS_H;
constexpr size_t WS_BG = WS_H + 48 * MiB;
constexpr size_t WS_QM = WS_H + 96 * MiB;
constexpr size_t WS_Y = WS_H + 112 * MiB;
constexpr size_t WS_Q = WS_H;
constexpr size_t WS_CTL = 370 * MiB, CTL_BYTES = 65536;
constexpr size_t WS_END = 371 * MiB;

constexpr int LDS_BYTES = 147456;
#define LAS __attribute__((address_space(3)))
typedef unsigned short bf16;
typedef unsigned v4u __attribute__((ext_vector_type(4)));
typedef unsigned v2u __attribute__((ext_vector_type(2)));
typedef float f32x4 __attribute__((ext_vector_type(4)));
typedef float f32x16 __attribute__((ext_vector_type(16)));
typedef short bf16x8 __attribute__((ext_vector_type(8)));
typedef short s16x4 __attribute__((ext_vector_type(4)));
#define LDS_WAIT() asm volatile("s_waitcnt lgkmcnt(0)" ::: "memory")
__device__ __forceinline__ unsigned f2bf(float f) { unsigned u = __builtin_bit_cast(unsigned, f); return (u + 0x7fffu + ((u >> 16) & 1u)) >> 16; }
__device__ __forceinline__ unsigned pk2(float lo, float hi) { return pg8::cvt_pk_bf16(lo, hi); }
__device__ __forceinline__ float bflo(unsigned u) { return __builtin_bit_cast(float, u << 16); }
__device__ __forceinline__ float bfhi(unsigned u) { return __builtin_bit_cast(float, u & 0xffff0000u); }
__device__ __forceinline__ float wave_sum(float v) {
#pragma unroll
    for (int o = 1; o < 64; o <<= 1) v += __shfl_xor(v, o);
    return v;
}

struct Args { const float* in[19]; float* out; unsigned char* ws; };
typedef const Args __attribute__((address_space(4)))* CArgsP;
__device__ __forceinline__ CArgsP kargs() { CArgsP p = (CArgsP)__builtin_amdgcn_kernarg_segment_ptr(); asm volatile("" : "+s"(p)); return p; }
enum { I_X = 0, I_MEM, I_NORM_MIX, I_NORM_FFN, I_A_W_IN, I_A_CONV_W, I_A_W_OUT, I_KV_NORM, I_W_KV, I_B_W_Q, I_B_SINKS, I_B_W_OUT, I_REL_BIAS, I_MEM_NORM, I_W_MEM_KV, I_W_GATE, I_W_UP, I_W_DOWN, I_FINAL_NORM };

template <bool HAS_GAIN>
__device__ __forceinline__ void transpose_item(const float* W, int K, int Nsrc, const float* gain, bf16* WT, int dst_row0, int k0, int n0, LAS float* scr, int lane) {
    const int c = lane & 7;
    f32x4 g0 = {1.f, 1.f, 1.f, 1.f}, g1 = {1.f, 1.f, 1.f, 1.f};
    if (HAS_GAIN) { g0 = *(const f32x4*)(gain + k0 + 8 * c); g1 = *(const f32x4*)(gain + k0 + 8 * c + 4); }
#pragma unroll
    for (int i = 0; i < 32; ++i) { const int kk = 2 * i + (lane >> 5); scr[kk * 33 + (lane & 31)] = __builtin_nontemporal_load(W + (size_t)(k0 + kk) * Nsrc + n0 + (lane & 31)); }
    LDS_WAIT(); asm volatile("" ::: "memory");
#pragma unroll
    for (int j = 0; j < 4; ++j) { const int n = (lane >> 3) + 8 * j; const LAS float* s = scr + (8 * c) * 33 + n;
        v4u o; o.x = pk2(s[0 * 33] * g0[0], s[1 * 33] * g0[1]); o.y = pk2(s[2 * 33] * g0[2], s[3 * 33] * g0[3]); o.z = pk2(s[4 * 33] * g1[0], s[5 * 33] * g1[1]); o.w = pk2(s[6 * 33] * g1[2], s[7 * 33] * g1[3]);
        *(v4u*)(WT + (size_t)(dst_row0 + n) * K + k0 + 8 * c) = o; }
    LDS_WAIT(); asm volatile("" ::: "memory");
}
__device__ __forceinline__ void prologue(LAS unsigned char* lds, int gw, int NGW, int wave, int lane) {
    const CArgsP ka = kargs(); unsigned char* ws = ka->ws;
    LAS float* scr = (LAS float*)(lds + wave * 16384);
    constexpr int N_AIN = 16 * 80, N_SQ = 16 * 32, N_KV = 16 * 16, N_FF = 16 * 88, N_DN = 44 * 32;
    constexpr int NITEMS = 2 * N_AIN + 2 * N_SQ + N_KV + 2 * N_SQ + 2 * N_SQ + 4 * N_KV + 4 * N_FF + 4 * N_FF + 4 * N_DN;
    for (int it = gw; it < NITEMS; it += NGW) {
        int r = it;
        if (r < 2 * N_AIN) { const int l = r / N_AIN; r %= N_AIN; const int kb = r / 80, nb = r % 80, n0 = 32 * nb;
            int dst; if (n0 < 768) dst = 256 * (n0 / 128) + (n0 % 128); else if (n0 < 1536) dst = 1536 + (n0 - 768); else if (n0 < 2304) dst = 256 * ((n0 - 1536) / 128) + 128 + ((n0 - 1536) % 128); else dst = n0;
            transpose_item<true>(ka->in[I_A_W_IN] + (size_t)l * D * APROJ, D, APROJ, ka->in[I_NORM_MIX] + l * D, (bf16*)(ws + WS_WAIN) + (size_t)l * APROJ * D, dst, 64 * kb, n0, scr, lane); continue; }
        r -= 2 * N_AIN;
        if (r < 2 * N_SQ) { const int l = r / N_SQ; r %= N_SQ; const int kb = r / 32, nb = r % 32;
            transpose_item<false>(ka->in[I_A_W_OUT] + (size_t)l * D * D, D, D, nullptr, (bf16*)(ws + WS_WAOUT) + (size_t)l * D * D, 32 * nb, 64 * kb, 32 * nb, scr, lane); continue; }
        r -= 2 * N_SQ;
        if (r < N_KV) { const int kb = r / 16, nb = r % 16;
            transpose_item<true>(ka->in[I_W_KV], D, 512, ka->in[I_KV_NORM], (bf16*)(ws + WS_WKV), (nb < 8 ? 256 + 32 * nb : 32 * (nb - 8)), 64 * kb, 32 * nb, scr, lane); continue; }
        r -= N_KV;
        if (r < 2 * N_SQ) { const int l = r / N_SQ; r %= N_SQ; const int kb = r / 32, nb = r % 32;
            transpose_item<true>(ka->in[I_B_W_Q] + (size_t)l * D * D, D, D, ka->in[I_NORM_MIX] + (2 + l) * D, (bf16*)(ws + WS_WBQ) + (size_t)l * D * D, 32 * nb, 64 * kb, 32 * nb, scr, lane); continue; }
        r -= 2 * N_SQ;
        if (r < 2 * N_SQ) { const int l = r / N_SQ; r %= N_SQ; const int kb = r / 32, nb = r % 32;
            transpose_item<false>(ka->in[I_B_W_OUT] + (size_t)l * D * D, D, D, nullptr, (bf16*)(ws + WS_WBOUT) + (size_t)l * D * D, 32 * nb, 64 * kb, 32 * nb, scr, lane); continue; }
        r -= 2 * N_SQ;
        if (r < 4 * N_KV) { const int l = r / N_KV; r %= N_KV; const int kb = r / 16, nb = r % 16;
            transpose_item<false>(ka->in[I_W_MEM_KV] + (size_t)l * D * 512, D, 512, nullptr, (bf16*)(ws + WS_WMEMKV), (nb < 8 ? 256 * l + 32 * nb : 1024 + 256 * l + 32 * (nb - 8)), 64 * kb, 32 * nb, scr, lane); continue; }
        r -= 4 * N_KV;
        if (r < 8 * N_FF) { const int which = r / (4 * N_FF); r %= 4 * N_FF; const int l = r / N_FF; r %= N_FF; const int kb = r / 88, nb = r % 88, n0 = 32 * nb;
            const int dst = 256 * (n0 / 128) + 128 * which + (n0 % 128);
            transpose_item<true>((which ? ka->in[I_W_UP] : ka->in[I_W_GATE]) + (size_t)l * D * DFF, D, DFF, ka->in[I_NORM_FFN] + l * D, (bf16*)(ws + WS_WUP) + (size_t)l * 2 * DFF * D, dst, 64 * kb, n0, scr, lane); continue; }
        r -= 8 * N_FF;
        { const int l = r / N_DN; r %= N_DN; const int kb = r / 32, nb = r % 32;
            transpose_item<false>(ka->in[I_W_DOWN] + (size_t)l * DFF * D, DFF, D, nullptr, (bf16*)(ws + WS_WDOWN) + (size_t)l * D * DFF, 32 * nb, 64 * kb, 32 * nb, scr, lane); }
    }
    const float* x = ka->in[I_X]; bf16* XB = (bf16*)(ws + WS_XB); float* ssqp = (float*)(ws + WS_SSQ);
    for (int m0 = gw; m0 < M; m0 += 4 * NGW) {
        f32x4 v[4][4];
#pragma unroll
        for (int q = 0; q < 4; ++q) { const f32x4* xr = (const f32x4*)(x + (size_t)(m0 + q * NGW) * D) + lane;
#pragma unroll
            for (int j = 0; j < 4; ++j) v[q][j] = __builtin_nontemporal_load(xr + 64 * j); }
#pragma unroll
        for (int q = 0; q < 4; ++q) { const int m = m0 + q * NGW; float s = 0.f;
#pragma unroll
            for (int j = 0; j < 4; ++j) s += (v[q][j].x * v[q][j].x + v[q][j].y * v[q][j].y) + (v[q][j].z * v[q][j].z + v[q][j].w * v[q][j].w);
            s = wave_sum(s);
            unsigned long long* o8 = (unsigned long long*)(XB + (size_t)m * D) + lane;
#pragma unroll
            for (int j = 0; j < 4; ++j) o8[64 * j] = (unsigned long long)pk2(v[q][j].x, v[q][j].y) | ((unsigned long long)pk2(v[q][j].z, v[q][j].w) << 32);
            if (lane < 16) ssqp[(size_t)m * 16 + lane] = lane == 0 ? s : 0.f; }
    }
    const float* mem = ka->in[I_MEM]; const float* mg = ka->in[I_MEM_NORM]; bf16* MEMN = (bf16*)(ws + WS_MEMN);
    for (int m = gw; m < BATCH * NMEM; m += NGW) {
        const f32x4* xr = (const f32x4*)(mem + (size_t)m * D) + lane; const f32x4* gr = (const f32x4*)mg + lane; f32x4 v[4]; float s = 0.f;
#pragma unroll
        for (int j = 0; j < 4; ++j) { v[j] = xr[64 * j]; s += (v[j].x * v[j].x + v[j].y * v[j].y) + (v[j].z * v[j].z + v[j].w * v[j].w); }
        const float rstd = 1.0f / sqrtf(wave_sum(s) * (1.0f / D) + EPS);
        unsigned long long* o8 = (unsigned long long*)(MEMN + (size_t)m * D) + lane;
#pragma unroll
        for (int j = 0; j < 4; ++j) { const f32x4 g = gr[64 * j]; const f32x4 y = v[j] * rstd * g; o8[64 * j] = (unsigned long long)pk2(y.x, y.y) | ((unsigned long long)pk2(y.z, y.w) << 32); }
    }
}

__device__ __forceinline__ unsigned cvtpk(float lo, float hi) { return pg8::cvt_pk_bf16(lo, hi); }
__device__ __forceinline__ void softmax_block(f32x16& S, float& m, float& l, f32x16& o0, f32x16& o1, bf16x8& p0, bf16x8& p1) {
    float bm = fmaxf(S[0], S[1]);
#pragma unroll
    for (int i = 2; i < 16; ++i) bm = fmaxf(bm, S[i]);
    bm = fmaxf(bm, __shfl_xor(bm, 32));
    const float mn = fmaxf(m, bm);
    const float alpha = __builtin_amdgcn_exp2f(m - mn);
    m = mn;
    float sum = 0.f;
#pragma unroll
    for (int i = 0; i < 16; ++i) { S[i] = __builtin_amdgcn_exp2f(S[i] - mn); sum += S[i]; }
    l = l * alpha + sum;
#pragma unroll
    for (int i = 0; i < 16; ++i) { o0[i] *= alpha; o1[i] *= alpha; }
    v4u w0, w1;
    w0.x = cvtpk(S[0], S[1]); w0.y = cvtpk(S[2], S[3]); w0.z = cvtpk(S[4], S[5]); w0.w = cvtpk(S[6], S[7]);
    w1.x = cvtpk(S[8], S[9]); w1.y = cvtpk(S[10], S[11]); w1.z = cvtpk(S[12], S[13]); w1.w = cvtpk(S[14], S[15]);
    p0 = __builtin_bit_cast(bf16x8, w0); p1 = __builtin_bit_cast(bf16x8, w1);
}
__device__ __forceinline__ void attn_store(const f32x16& o0, const f32x16& o1, float l, bf16* yrow, int hi) {
    l += __shfl_xor(l, 32);
    const float inv = 1.0f / l;
#pragma unroll
    for (int g = 0; g < 4; ++g) {
        v2u w; w.x = pk2(o0[4 * g] * inv, o0[4 * g + 1] * inv); w.y = pk2(o0[4 * g + 2] * inv, o0[4 * g + 3] * inv); *(v2u*)(yrow + 8 * g + 4 * hi) = w;
        v2u z; z.x = pk2(o1[4 * g] * inv, o1[4 * g + 1] * inv); z.y = pk2(o1[4 * g + 2] * inv, o1[4 * g + 3] * inv); *(v2u*)(yrow + 32 + 8 * g + 4 * hi) = z;
    }
}
constexpr int KIMG_STRIDE = 144, VIMG_STRIDE = 528, KIMG_BYTES = 256 * KIMG_STRIDE, VIMG_BYTES = 64 * VIMG_STRIDE, TAB_OFF = KIMG_BYTES + VIMG_BYTES;
__device__ __forceinline__ void mem_stage(LAS unsigned char* lds, const bf16* MK, const bf16* MVT, int layer, int b, int h, int tid) {
    const bf16* ksrc = MK + ((size_t)layer * 512 + b * 256) * 256 + h * 64;
    for (int i = tid; i < 256 * 8; i += NTHREADS) { const int key = i >> 3, c = i & 7; *(LAS v4u*)(lds + key * KIMG_STRIDE + c * 16) = *(const v4u*)(ksrc + (size_t)key * 256 + c * 8); }
    const bf16* vsrc = MVT + ((size_t)(layer * 2 + b) * 256 + h * 64) * 256;
    for (int i = tid; i < 64 * 32; i += NTHREADS) { const int d = i >> 5, c = i & 31; *(LAS v4u*)(lds + KIMG_BYTES + d * VIMG_STRIDE + c * 16) = *(const v4u*)(vsrc + (size_t)d * 256 + c * 8); }
    __syncthreads();
}
__device__ __forceinline__ void mem_attn_unit(LAS unsigned char* lds, const bf16* q, int ldq, bf16* y, int ldy, int lane) {
    const int r = lane & 31, hi = lane >> 5;
    bf16x8 qf[4];
#pragma unroll
    for (int s = 0; s < 4; ++s) qf[s] = *(const bf16x8*)(q + (size_t)r * ldq + 16 * s + 8 * hi);
    float m = -1e30f, l = 0.f; f32x16 o0 = {}, o1 = {};
    for (int kb = 0; kb < 8; ++kb) {
        f32x16 S = {};
#pragma unroll
        for (int s = 0; s < 4; ++s) { const bf16x8 kf = *(const LAS bf16x8*)(lds + (kb * 32 + r) * KIMG_STRIDE + (16 * s + 8 * hi) * 2); S = __builtin_amdgcn_mfma_f32_32x32x16_bf16(kf, qf[s], S, 0, 0, 0); }
        bf16x8 p0, p1; softmax_block(S, m, l, o0, o1, p0, p1);
#pragma unroll
        for (int s = 0; s < 2; ++s) {
            const bf16x8 pb = s ? p1 : p0;
#pragma unroll
            for (int db = 0; db < 2; ++db) {
                const LAS unsigned char* vp = lds + KIMG_BYTES + (db * 32 + r) * VIMG_STRIDE + (kb * 32 + 16 * s + 4 * hi) * 2;
                const s16x4 a = *(const LAS s16x4*)vp, c = *(const LAS s16x4*)(vp + 16);
                const bf16x8 vf = (bf16x8){a[0], a[1], a[2], a[3], c[0], c[1], c[2], c[3]};
                if (db == 0) o0 = __builtin_amdgcn_mfma_f32_32x32x16_bf16(vf, pb, o0, 0, 0, 0); else o1 = __builtin_amdgcn_mfma_f32_32x32x16_bf16(vf, pb, o1, 0, 0, 0);
            }
        }
    }
    attn_store(o0, o1, l, y + (size_t)r * ldy, hi);
}
__device__ __forceinline__ void mem_attn_phase(LAS unsigned char* lds, const bf16* MK, const bf16* MVT, int layer, const bf16* Q, int ldq, int qcol0, bf16* Y, int tid, int wave, int lane) {
    const int G = gridDim.x, bh = blockIdx.x & 7, b = bh >> 2, h = bh & 3, slot = blockIdx.x >> 3, nslots = (G - bh + 7) >> 3;
    mem_stage(lds, MK, MVT, layer, b, h, tid);
    for (int g = slot * NWAVES + wave; g < SEQ / 32; g += nslots * NWAVES) {
        const size_t row0 = (size_t)b * SEQ + (size_t)g * 32;
        mem_attn_unit(lds, Q + row0 * ldq + qcol0 + h * 64, ldq, Y + row0 * D + CONVW + h * 64, D, lane);
    }
    __syncthreads();
}

__device__ __forceinline__ void conv_phase(const bf16* V, const bf16* BG, const float* cw, bf16* Y, int gtid, int nthreads) {
    constexpr int NCH = CONVW / 8;
    for (int idx = gtid; idx < (M / 4) * NCH; idx += nthreads) {
        const int rg = idx / NCH, ch = idx % NCH, c0 = ch * 8, t0 = rg * 4, tl = t0 % SEQ;
        float w0[8], w1[8], w2[8];
#pragma unroll
        for (int j = 0; j < 8; j += 4) { const f32x4 a = *(const f32x4*)(cw + c0 + j), b = *(const f32x4*)(cw + CONVW + c0 + j), c = *(const f32x4*)(cw + 2 * CONVW + c0 + j);
#pragma unroll
            for (int e = 0; e < 4; ++e) { w0[j + e] = a[e]; w1[j + e] = b[e]; w2[j + e] = c[e]; } }
        float vm2[8], vm1[8];
        if (tl != 0) { const v4u a = *(const v4u*)(V + (size_t)(t0 - 2) * CONVW + c0), b = *(const v4u*)(V + (size_t)(t0 - 1) * CONVW + c0);
#pragma unroll
            for (int e = 0; e < 4; ++e) { vm2[2 * e] = bflo(a[e]); vm2[2 * e + 1] = bfhi(a[e]); vm1[2 * e] = bflo(b[e]); vm1[2 * e + 1] = bfhi(b[e]); } }
        else {
#pragma unroll
            for (int e = 0; e < 8; ++e) { vm2[e] = 0.f; vm1[e] = 0.f; } }
#pragma unroll
        for (int rr = 0; rr < 4; ++rr) {
            const v4u vv = *(const v4u*)(V + (size_t)(t0 + rr) * CONVW + c0), gg = *(const v4u*)(BG + (size_t)(t0 + rr) * CONVW + c0);
            float v[8], g[8], yv[8];
#pragma unroll
            for (int e = 0; e < 4; ++e) { v[2 * e] = bflo(vv[e]); v[2 * e + 1] = bfhi(vv[e]); g[2 * e] = bflo(gg[e]); g[2 * e + 1] = bfhi(gg[e]); }
#pragma unroll
            for (int e = 0; e < 8; ++e) { yv[e] = g[e] * (w0[e] * vm2[e] + w1[e] * vm1[e] + w2[e] * v[e]); vm2[e] = vm1[e]; vm1[e] = v[e]; }
            v4u o; o.x = pk2(yv[0], yv[1]); o.y = pk2(yv[2], yv[3]); o.z = pk2(yv[4], yv[5]); o.w = pk2(yv[6], yv[7]);
            *(v4u*)(Y + (size_t)(t0 + rr) * D + c0) = o;
        }
    }
}

constexpr int SK_STRIDE = 144, SK_BYTES = 384 * SK_STRIDE, SV_STRIDE = 776, SV_BYTES = 64 * SV_STRIDE, STAB_OFF = SK_BYTES + SV_BYTES;
static_assert(STAB_OFF + 12 * 128 * 4 <= 131072, "swa LDS map");
__device__ __forceinline__ void swa_unit(LAS unsigned char* lds, const LAS float* tab, const bf16* Q, bf16* Y, size_t row0, int tl0, int w, int qh, float sink2, int lane) {
    const int r = lane & 31, hi = lane >> 5;
    bf16x8 qf[4];
#pragma unroll
    for (int s = 0; s < 4; ++s) qf[s] = *(const bf16x8*)(Q + (row0 + r) * D + qh * 64 + 16 * s + 8 * hi);
    float m = sink2, l = hi == 0 ? 1.0f : 0.0f; f32x16 o0 = {}, o1 = {};
    const LAS float* tb = tab + qh * 128;
    const int kb0 = tl0 >= 128 ? 0 : (128 - tl0) >> 5;
    for (int kb = kb0; kb < 5; ++kb) {
        const int j0 = 32 * w + 32 * kb;
        f32x16 S = {};
#pragma unroll
        for (int s = 0; s < 4; ++s) { const bf16x8 kf = *(const LAS bf16x8*)(lds + (j0 + r) * SK_STRIDE + (16 * s + 8 * hi) * 2); S = __builtin_amdgcn_mfma_f32_32x32x16_bf16(kf, qf[s], S, 0, 0, 0); }
#pragma unroll
        for (int i = 0; i < 16; ++i) { const int krow = (i & 3) + 8 * (i >> 2) + 4 * hi; const int dist = 128 - 32 * kb + r - krow;
            S[i] = ((unsigned)dist < 128u) ? S[i] + tb[dist & 127] : -1e30f; }
        bf16x8 p0, p1; softmax_block(S, m, l, o0, o1, p0, p1);
#pragma unroll
        for (int s = 0; s < 2; ++s) {
            const bf16x8 pb = s ? p1 : p0;
#pragma unroll
            for (int db = 0; db < 2; ++db) {
                const LAS unsigned char* vp = lds + SK_BYTES + (db * 32 + r) * SV_STRIDE + (j0 + 16 * s + 4 * hi) * 2;
                const s16x4 a = *(const LAS s16x4*)vp, c = *(const LAS s16x4*)(vp + 16);
                const bf16x8 vf = (bf16x8){a[0], a[1], a[2], a[3], c[0], c[1], c[2], c[3]};
                if (db == 0) o0 = __builtin_amdgcn_mfma_f32_32x32x16_bf16(vf, pb, o0, 0, 0, 0); else o1 = __builtin_amdgcn_mfma_f32_32x32x16_bf16(vf, pb, o1, 0, 0, 0);
            }
        }
    }
    attn_store(o0, o1, l, Y + (row0 + r) * D + qh * 64, hi);
}
__device__ __forceinline__ void swa_phase(LAS unsigned char* lds, const float* rel_bias, const float* sinks, const bf16* Q, const bf16* KB, const bf16* VT, bf16* Y, int tid, int wave, int lane) {
    LAS float* tab = (LAS float*)(lds + STAB_OFF);
    for (int i = tid; i < 12 * 128; i += NTHREADS) { const int h = i >> 7, d = i & 127;
        int bucket = d; if (d >= 16) { bucket = 16 + (int)(log2f((float)d * (1.0f / 16.0f)) * (16.0f / 3.0f)); bucket = bucket > 31 ? 31 : bucket; }
        tab[i] = rel_bias[bucket * 12 + h] * LOG2E; }
    const int G = gridDim.x;
    for (int task = blockIdx.x; task < 4 * (M / 256); task += G) {
        const int kvh = task & 3, chunk = task >> 2, b = chunk / (SEQ / 256), tlc = (chunk % (SEQ / 256)) * 256;
        __syncthreads();
        const int jlo = tlc == 0 ? 128 : 0;
        const bf16* ksrc = KB + ((size_t)b * SEQ + tlc - 128) * 256 + kvh * 64;
        for (int i = tid; i < 384 * 8; i += NTHREADS) { const int j = i >> 3, c = i & 7; if (j >= jlo) *(LAS v4u*)(lds + j * SK_STRIDE + c * 16) = *(const v4u*)(ksrc + (size_t)j * 256 + c * 8); }
        const bf16* vsrc = VT + (size_t)(kvh * 64) * M + (size_t)b * SEQ + tlc - 128;
        for (int i = tid; i < 64 * 96; i += NTHREADS) { const int d = i / 96, c = i % 96; if (c * 4 >= jlo) *(LAS v2u*)(lds + SK_BYTES + d * SV_STRIDE + c * 8) = *(const v2u*)(vsrc + (size_t)d * M + c * 4); }
        __syncthreads();
        const int tl0 = tlc + wave * 32; const size_t row0 = (size_t)b * SEQ + tl0;
        for (int g = 0; g < 3; ++g) { const int qh = kvh * 3 + g; swa_unit(lds, tab, Q, Y, row0, tl0, wave, qh, sinks[qh] * LOG2E, lane); }
    }
    __syncthreads();
}

__device__ __forceinline__ void final_phase(const bf16* XBs, float* out, const float* g, int gw, int NGW, int lane) {
    const f32x4* gr = (const f32x4*)g + lane;
    for (int m0 = gw; m0 < M; m0 += 4 * NGW) {
        v2u v[4][4];
#pragma unroll
        for (int q = 0; q < 4; ++q) { const v2u* xr = (const v2u*)(XBs + (size_t)(m0 + q * NGW) * D) + lane;
#pragma unroll
            for (int j = 0; j < 4; ++j) v[q][j] = xr[64 * j]; }
#pragma unroll
        for (int q = 0; q < 4; ++q) { f32x4* orow = (f32x4*)(out + (size_t)(m0 + q * NGW) * D) + lane; f32x4 f[4]; float s = 0.f;
#pragma unroll
            for (int j = 0; j < 4; ++j) { f[j] = (f32x4){bflo(v[q][j].x), bfhi(v[q][j].x), bflo(v[q][j].y), bfhi(v[q][j].y)}; s += (f[j].x * f[j].x + f[j].y * f[j].y) + (f[j].z * f[j].z + f[j].w * f[j].w); }
            const float rstd = 1.0f / sqrtf(wave_sum(s) * (1.0f / D) + EPS);
#pragma unroll
            for (int j = 0; j < 4; ++j) __builtin_nontemporal_store(f[j] * rstd * gr[64 * j], orow + 64 * j); }
    }
}

#define XB_TMO      128
#define XB_XCNT(j)  (256  + 64 * (j))
#define XB_XSUB(j)  (1280 + 64 * (j))
#define XB_XGEN(j)  (2304 + 64 * (j))
#define XB_TOP      3328
#define XB_TOPGEN   3392
#define XCD_BAR_WORDS 3456
#define XB_SPIN_CAP (1u << 18)

__device__ __forceinline__ unsigned xb_ld(unsigned* p)              { return __hip_atomic_load(p, __ATOMIC_RELAXED, __HIP_MEMORY_SCOPE_AGENT); }
__device__ __forceinline__ unsigned xb_add(unsigned* p, unsigned v) { return __hip_atomic_fetch_add(p, v, __ATOMIC_RELAXED, __HIP_MEMORY_SCOPE_AGENT); }
__device__ __forceinline__ unsigned xb_xcc_id() { return (unsigned)__builtin_amdgcn_s_getreg((3 << 11) | 20) & 0xFu; }
#define XB_SPIN(cond, bar) do { unsigned _sp = 0; while (cond) { __builtin_amdgcn_s_sleep(1); \
    if ((++_sp & 255u) == 0u) { if (xb_ld(&(bar)[XB_TMO])) break; if (_sp > XB_SPIN_CAP) { atomicAdd(&(bar)[XB_TMO], 1u); break; } } } } while (0)

struct XcdBarrier {
    unsigned* bar; unsigned x;
    volatile LAS unsigned* st;
};

__device__ __forceinline__ XcdBarrier xcd_barrier_post(unsigned* bar, volatile LAS unsigned* st) {
    XcdBarrier b; b.bar = bar; b.x = xb_xcc_id(); b.st = st;
    if (threadIdx.x == 0) (void)xb_add(&bar[XB_XCNT(b.x)], 1u);
    return b;
}
__device__ __forceinline__ void xcd_barrier_complete(unsigned* bar, unsigned x, unsigned& nloc, unsigned& nx) {
    const unsigned G = gridDim.x * gridDim.y * gridDim.z;
    unsigned sum, cnt, mine, sp = 0u;
    for (;;) {
        sum = 0u; cnt = 0u; mine = 0u;
#pragma unroll
        for (unsigned j = 0; j < 16; ++j) { const unsigned c = xb_ld(&bar[XB_XCNT(j)]); sum += c; cnt += (c > 0u) ? 1u : 0u; mine = (j == x) ? c : mine; }
        if (sum == G) break;
        __builtin_amdgcn_s_sleep(1);
        if ((++sp & 255u) == 0u) { if (xb_ld(&bar[XB_TMO])) break; if (sp > XB_SPIN_CAP) { atomicAdd(&bar[XB_TMO], 1u); break; } }
    }
    nloc = mine > 0u ? mine : 1u; nx = cnt > 0u ? cnt : 1u;
}

__device__ __forceinline__ void xcd_barrier(const XcdBarrier& b) {
    asm volatile("s_waitcnt vmcnt(0)" ::: "memory");
    __syncthreads();
    if (threadIdx.x == 0) {
        unsigned* bar = b.bar;
        __builtin_amdgcn_s_waitcnt(0);
        unsigned nloc = b.st[0], nx = b.st[1];
        if (nloc == 0u) { xcd_barrier_complete(bar, b.x, nloc, nx); b.st[0] = nloc; b.st[1] = nx; }
        const unsigned old = xb_add(&bar[XB_XSUB(b.x)], 1u);
        const unsigned gen = old / nloc;
        if (old + 1u == (gen + 1u) * nloc) {
            __builtin_amdgcn_fence(__ATOMIC_RELEASE, "agent");
            asm volatile("s_waitcnt vmcnt(0)" ::: "memory");
            const unsigned og = xb_add(&bar[XB_TOP], 1u);
            const unsigned tg = og / nx;
            if (og + 1u == (tg + 1u) * nx) xb_add(&bar[XB_TOPGEN], 1u);
            else XB_SPIN(xb_ld(&bar[XB_TOPGEN]) == tg, bar);
            __builtin_amdgcn_fence(__ATOMIC_ACQUIRE, "agent");
            xb_add(&bar[XB_XGEN(b.x)], 1u);
            asm volatile("s_waitcnt vmcnt(0)" ::: "memory");
        } else {
            XB_SPIN(xb_ld(&bar[XB_XGEN(b.x)]) == gen, bar);
            __builtin_amdgcn_fence(__ATOMIC_ACQUIRE, "agent");
            asm volatile("s_waitcnt vmcnt(0)" ::: "memory");
        }
    }
    __syncthreads();
}

#define GRID_SYNC() do { XcdBarrier b_; b_.bar = (unsigned*)(kargs()->ws + WS_CTL); b_.x = xb_xcc_id(); b_.st = (volatile LAS unsigned*)(lds + 131072) + 8; xcd_barrier(b_); } while (0)
enum StepType { ST_AIN = 0, ST_MIXA, ST_RES, ST_UP, ST_KVQ, ST_ATTB, ST_FINAL };
__global__ void __launch_bounds__(NTHREADS, 2) yoco_fwd(Args a) {
    extern __shared__ __attribute__((aligned(16))) unsigned char lds_raw[];
    cg::grid_group grid = cg::this_grid();
    LAS unsigned char* lds = (LAS unsigned char*)lds_raw;
    const int tid = threadIdx.x, lane = tid & 63, wave = __builtin_amdgcn_readfirstlane(tid >> 6), G = gridDim.x;
    const int gw = blockIdx.x * NWAVES + wave, NGW = G * NWAVES;
    { unsigned char* ws = kargs()->ws;

    volatile LAS unsigned* MISC = (volatile LAS unsigned*)(lds + 131072);
    if (tid < 64) MISC[tid] = 0u;
    __syncthreads();
    (void)xcd_barrier_post((unsigned*)(ws + WS_CTL), MISC + 8);

    prologue(lds, gw, NGW, wave, lane);
    GRID_SYNC(); }

    for (int step = 0; step < 21; ++step) {
        int type, layer, sub = 0;
        if (step < 20) { layer = step / 5; const int k = step % 5; sub = (k == 4);
            type = (k == 0) ? (layer < 2 ? ST_AIN : ST_KVQ) : (k == 1) ? (layer < 2 ? ST_MIXA : ST_ATTB) : (k == 3) ? ST_UP : ST_RES; }
        else { type = ST_FINAL; layer = 3; }
        int tidv = threadIdx.x; asm volatile("" : "+v"(tidv));
        const int lanev = tidv & 63, wavev = __builtin_amdgcn_readfirstlane(tidv >> 6);
        const CArgsP ka = kargs(); unsigned char* ws = ka->ws;
        float* ssqp = (float*)(ws + WS_SSQ); bf16* XB = (bf16*)(ws + WS_XB); bf16* Hb = (bf16*)(ws + WS_H); bf16* Yb = (bf16*)(ws + WS_Y); bf16* MK = (bf16*)(ws + WS_MK); bf16* MVT = (bf16*)(ws + WS_MVT);
        switch (type) {
        case ST_AIN: {
            if (layer == 0) {
                { pg8::Gemm g{(const bf16*)(ws + WS_MEMN), (const bf16*)(ws + WS_WMEMKV), 512, 1024, D}; pg8::StaticOrder S; S.init(512, 1024, G, (int)blockIdx.x);
                  pg8::EpiRowScale E{MK, 256, (const LAS float*)nullptr, 1.0f, (size_t)512 * 256, nullptr, 0};
                  pg8::gemm_phase<pg8::EpiRowScale, pg8::StaticOrder, true, true>(lds, g, S, E, tidv); }
                { pg8::Gemm g{(const bf16*)(ws + WS_WMEMKV) + (size_t)1024 * D, (const bf16*)(ws + WS_MEMN), 1024, 512, D}; pg8::StaticOrder S; S.init(1024, 512, G, (int)((blockIdx.x + G - 8) % G));
                  pg8::EpiVT E{MVT, 256, nullptr, (size_t)2 * 65536, (size_t)65536};
                  pg8::gemm_phase<pg8::EpiVT, pg8::StaticOrder, true, true>(lds, g, S, E, tidv); }
            }
            pg8::Gemm g{XB, (const bf16*)(ws + WS_WAIN) + (size_t)layer * APROJ * D, M, APROJ, D}; pg8::StaticOrder S; S.init(M, APROJ, G, (int)blockIdx.x);
            pg8::fill_rstd(lds, ssqp, S, tidv);
            pg8::EpiAIn E{(bf16*)(ws + WS_V), (bf16*)(ws + WS_BG), (bf16*)(ws + WS_QM), (const LAS float*)(lds + pg8::RSTAB_OFF), QSCALE};
            pg8::gemm_phase<pg8::EpiAIn, pg8::StaticOrder, true, true>(lds, g, S, E, tidv);
        } break;
        case ST_MIXA: {
            conv_phase((const bf16*)(ws + WS_V), (const bf16*)(ws + WS_BG), ka->in[I_A_CONV_W] + (size_t)layer * 3 * CONVW, Yb, blockIdx.x * NTHREADS + tidv, G * NTHREADS);
            mem_attn_phase(lds, MK, MVT, layer, (const bf16*)(ws + WS_QM), 256, 0, Yb, tidv, wavev, lanev);
        } break;
        case ST_RES: {
            const bf16* A = sub ? Hb : Yb; const int K = sub ? DFF : D;
            const bf16* Bt = sub ? (const bf16*)(ws + WS_WDOWN) + (size_t)layer * D * DFF : (layer < 2 ? (const bf16*)(ws + WS_WAOUT) + (size_t)layer * D * D : (const bf16*)(ws + WS_WBOUT) + (size_t)(layer - 2) * D * D);
            pg8::Gemm g{A, Bt, M, D, K}; pg8::StaticOrder S; S.init(M, D, G, (int)blockIdx.x);
            pg8::EpiRes E{XB, ssqp};
            pg8::gemm_phase<pg8::EpiRes, pg8::StaticOrder, true, true>(lds, g, S, E, tidv);
        } break;
        case ST_UP: {
            pg8::Gemm g{XB, (const bf16*)(ws + WS_WUP) + (size_t)layer * 2 * DFF * D, M, 2 * DFF, D}; pg8::StaticOrder S; S.init(M, 2 * DFF, G, (int)blockIdx.x);
            pg8::fill_rstd(lds, ssqp, S, tidv);
            pg8::EpiSwiglu E{Hb, (const LAS float*)(lds + pg8::RSTAB_OFF)};
            pg8::gemm_phase<pg8::EpiSwiglu, pg8::StaticOrder, true, true>(lds, g, S, E, tidv);
        } break;
        case ST_KVQ: {
            if (layer == 2) {
                pg8::Gemm g{(const bf16*)(ws + WS_WKV), XB, 256, M, D}; pg8::StaticOrder S; S.init(256, M, G, (int)((blockIdx.x + G - 128) % G));
                pg8::EpiVT E{(bf16*)(ws + WS_VT), M, ssqp, (size_t)0, (size_t)256};
                pg8::gemm_phase<pg8::EpiVT, pg8::StaticOrder, true, true>(lds, g, S, E, tidv);
            }
            const int pn0 = layer == 2 ? 1 : 0;
            pg8::Gemm g{XB, layer == 2 ? (const bf16*)(ws + WS_WKV) + (size_t)256 * D : (const bf16*)(ws + WS_WBQ) + (size_t)D * D, M, D + 256 * pn0, D}; pg8::StaticOrder S; S.init(M, D + 256 * pn0, G, (int)blockIdx.x);
            pg8::fill_rstd(lds, ssqp, S, tidv);
            pg8::EpiRowScale E{(bf16*)(ws + WS_Q), D, (const LAS float*)(lds + pg8::RSTAB_OFF), QSCALE, (size_t)256, (bf16*)(ws + WS_KB), pn0};
            pg8::gemm_phase<pg8::EpiRowScale, pg8::StaticOrder, true, true>(lds, g, S, E, tidv);
        } break;
        case ST_ATTB: {
            swa_phase(lds, ka->in[I_REL_BIAS], ka->in[I_B_SINKS] + (layer - 2) * 12, (const bf16*)(ws + WS_Q), (const bf16*)(ws + WS_KB), (const bf16*)(ws + WS_VT), Yb, tidv, wavev, lanev);
            mem_attn_phase(lds, MK, MVT, layer, (const bf16*)(ws + WS_Q), D, CONVW, Yb, tidv, wavev, lanev);
        } break;
        default: {
            final_phase(XB, ka->out, ka->in[I_FINAL_NORM], blockIdx.x * NWAVES + wavev, NGW, lanev);
        } break;
        }
        if (step < 20) GRID_SYNC();
    }
    if (kargs()->out == nullptr) grid.sync();
}

extern "C" void kernel_launch(void* const* d_in, const int* in_sizes, int n_in, void* d_out, int out_size, void* d_ws, size_t ws_size, hipStream_t stream) {
    static int grid = 0;
    if (grid == 0) {
        if (n_in != 19 || out_size != M * D || ws_size < WS_END) { fprintf(stderr, "kernel_launch: unexpected shapes (n_in %d out %d ws %zu)\n", n_in, out_size, ws_size); grid = -1; return; }
        int dev = 0, cus = 0, per_cu = 0;
        if (hipGetDevice(&dev) != hipSuccess || hipDeviceGetAttribute(&cus, hipDeviceAttributeMultiprocessorCount, dev) != hipSuccess) { grid = -1; return; }
        if (hipFuncSetAttribute((const void*)yoco_fwd, hipFuncAttributeMaxDynamicSharedMemorySize, LDS_BYTES) != hipSuccess) { fprintf(stderr, "kernel_launch: hipFuncSetAttribute failed\n"); grid = -1; return; }
        if (hipOccupancyMaxActiveBlocksPerMultiprocessor(&per_cu, (const void*)yoco_fwd, NTHREADS, LDS_BYTES) != hipSuccess || per_cu < 1) per_cu = 1;
        (void)hipGetLastError();
        grid = cus * per_cu;
        if (grid != 256) { fprintf(stderr, "kernel_launch: built for a 256-workgroup grid (one per CU), got %d\n", grid); grid = -1; return; }
    }
    if (grid < 0) return;
    if (hipMemsetAsync((char*)d_ws + WS_CTL, 0, CTL_BYTES, stream) != hipSuccess) { fprintf(stderr, "kernel_launch: memset failed\n"); return; }
    Args a{};
    for (int i = 0; i < 19; ++i) a.in[i] = (const float*)d_in[i];
    a.out = (float*)d_out; a.ws = (unsigned char*)d_ws;
    void* args[] = {&a};
    const hipError_t e = hipLaunchCooperativeKernel((const void*)yoco_fwd, dim3(grid), dim3(NTHREADS), args, LDS_BYTES, stream);
    if (e != hipSuccess) fprintf(stderr, "kernel_launch: cooperative launch failed: %s (grid %d)\n", hipGetErrorString(e), grid);
}
```

```cpp
#include <hip/hip_runtime.h>
#include <hip/hip_cooperative_groups.h>
#include <cstdio>
#include <cstdint>
namespace cg = cooperative_groups;
namespace pg8 {
#define PG8_LAS __attribute__((address_space(3)))
typedef unsigned short bf16_t;
typedef short bf16x8 __attribute__((ext_vector_type(8)));
typedef float f32x4 __attribute__((ext_vector_type(4)));
typedef unsigned u32x4 __attribute__((ext_vector_type(4)));
constexpr int BM = 256, BK = 64, HALF = 128, HTB = HALF * BK * 2  , STAGE_BYTES = 8 * HTB, NXCD = 8, WGM = 4;

__host__ __device__ __forceinline__ int lds_byte(int r, int c) { const int st = (r >> 4) * 2 + (c >> 5), rr = r & 15, cc = c & 31, ob = rr * 64 + cc * 2; return st * 1024 + (ob ^ (((ob >> 9) & 1) << 5)); }
__host__ __device__ __forceinline__ void stage_rc(int b, int& R, int& C) { const int st = b / 1024, sb = b % 1024, swz = sb ^ (((sb >> 9) & 1) << 5); R = (st >> 1) * 16 + swz / 64; C = (st & 1) * 32 + (swz % 64) / 2; }
__host__ __device__ __forceinline__ int perm32(int rho) { const int n = rho >> 4, i = rho & 15; return 8 * (i >> 2) + 4 * n + (i & 3); }

struct Unit { int pm, pn, ui; };
struct Gemm { const bf16_t* A; const bf16_t* Bt; int M, N, K; };

struct StaticOrder {
    int nM, nN, nwg, G, c;
    __host__ __device__ void init(int M, int N, int G_, int c_) { nM = M / BM; nN = N / BM; nwg = nM * nN; G = G_; c = c_; }
    __host__ __device__ bool next(int i, Unit& u) const {
        const long L = (long)i * G + c; if (L >= nwg) return false;
        int wgid = (int)L; { const int q = nwg / NXCD, r = nwg % NXCD, xcd = wgid % NXCD, off = wgid / NXCD; wgid = (xcd < r ? xcd * (q + 1) : r * (q + 1) + (xcd - r) * q) + off; }
        const int nig = WGM * nN, gid = wgid / nig, fm = gid * WGM, gsz = (nM - fm) < WGM ? (nM - fm) : WGM;
        u.pm = fm + ((wgid % nig) % gsz); u.pn = (wgid % nig) / gsz; u.ui = i; return true;
    }
    __device__ __forceinline__ void a_ready(const Unit&) const {}
    __device__ __forceinline__ void done(const Unit&) const {}
};
typedef float f32x2_t __attribute__((ext_vector_type(2))); typedef __bf16 bf16x2_t __attribute__((ext_vector_type(2)));
__device__ __forceinline__ unsigned cvt_pk_bf16(float lo, float hi) { f32x2_t v = {lo, hi}; bf16x2_t b = __builtin_convertvector(v, bf16x2_t); return __builtin_bit_cast(unsigned, b); }
typedef float f32x2 __attribute__((ext_vector_type(2)));
typedef unsigned u32x2 __attribute__((ext_vector_type(2)));
constexpr int DMODEL = 1024;
__device__ __forceinline__ float row_rstd(const float* ssqp, int row) {
    const f32x4* p = (const f32x4*)(ssqp + (size_t)row * 16);
    const f32x4 a = p[0], b = p[1], c = p[2], d = p[3];
    const f32x4 s = (a + b) + (c + d);
    const float t = (s[0] + s[1]) + (s[2] + s[3]);
    return __builtin_amdgcn_rsqf(t * (1.0f / 1024.0f) + 1e-5f);
}
constexpr int RSTAB_OFF = 132096;
template <class Sched> __device__ __forceinline__ void fill_rstd(PG8_LAS unsigned char* lds, const float* ssqp, const Sched& S, int tid) {
    PG8_LAS float* tab = (PG8_LAS float*)(lds + RSTAB_OFF); Unit u; const int row = tid >> 1, half = tid & 1;
    for (int i = 0; S.next(i, u); ++i) { const f32x4* p = (const f32x4*)(ssqp + (size_t)(u.pm * BM + row) * 16 + half * 8); const f32x4 a = p[0], b = p[1], s4 = a + b; float s = (s4[0] + s4[1]) + (s4[2] + s4[3]);
        s += __shfl_xor(s, 1); if (half == 0) tab[i * 256 + row] = __builtin_amdgcn_rsqf(s * (1.0f / 1024.0f) + 1e-5f); }
    __syncthreads();
}
__device__ __forceinline__ u32x4 pack8(f32x4 v0, f32x4 v1) { u32x4 w; w.x = cvt_pk_bf16(v0[0], v0[1]); w.y = cvt_pk_bf16(v0[2], v0[3]); w.z = cvt_pk_bf16(v1[0], v1[1]); w.w = cvt_pk_bf16(v1[2], v1[3]); return w; }
__device__ __forceinline__ unsigned short f2bf1(float f) { unsigned u = __builtin_bit_cast(unsigned, f); return (unsigned short)((u + 0x7fffu + ((u >> 16) & 1u)) >> 16); }

struct EpiAIn {
    static constexpr bool PERM = true, AFTER_DRAIN = false;
    bf16_t *V, *BG, *QM; const PG8_LAS float* rstab; float qscale;
    __device__ __forceinline__ void operator()(const f32x4 (&acc)[2][2][4][2], const Unit& u, int wr, int wc, int fr, int fq) const {
        const int row0 = u.pm * BM + wr * 64 + fr, cl = wc * 32 + 8 * fq; const PG8_LAS float* rt = rstab + u.ui * 256 + wr * 64 + fr;
        if (u.pn < 6) {
#pragma unroll
            for (int ai = 0; ai < 2; ++ai)
#pragma unroll
                for (int m = 0; m < 4; ++m) { const int row = row0 + ai * HALF + m * 16; const float r = rt[ai * HALF + m * 16], r2 = r * r;
                    *(u32x4*)(V + (size_t)row * 768 + u.pn * 128 + cl) = pack8(acc[ai][0][m][0] * acc[ai][1][m][0] * r2, acc[ai][0][m][1] * acc[ai][1][m][1] * r2); }
        } else if (u.pn < 9) {
#pragma unroll
            for (int ai = 0; ai < 2; ++ai)
#pragma unroll
                for (int m = 0; m < 4; ++m) { const int row = row0 + ai * HALF + m * 16; const float r = rt[ai * HALF + m * 16];
#pragma unroll
                    for (int bj = 0; bj < 2; ++bj) *(u32x4*)(BG + (size_t)row * 768 + (u.pn - 6) * 256 + bj * HALF + cl) = pack8(acc[ai][bj][m][0] * r, acc[ai][bj][m][1] * r); }
        } else {
#pragma unroll
            for (int ai = 0; ai < 2; ++ai)
#pragma unroll
                for (int m = 0; m < 4; ++m) { const int row = row0 + ai * HALF + m * 16; const float r = rt[ai * HALF + m * 16] * qscale;
#pragma unroll
                    for (int bj = 0; bj < 2; ++bj) *(u32x4*)(QM + (size_t)row * 256 + bj * HALF + cl) = pack8(acc[ai][bj][m][0] * r, acc[ai][bj][m][1] * r); }
        }
    }
};
struct EpiRowScale {
    static constexpr bool PERM = true, AFTER_DRAIN = false;
    bf16_t* O; int ldc; const PG8_LAS float* rstab; float scale; size_t pn_stride; bf16_t* KO; int pn0;
    __device__ __forceinline__ void operator()(const f32x4 (&acc)[2][2][4][2], const Unit& u, int wr, int wc, int fr, int fq) const {
        const int row0 = u.pm * BM + wr * 64 + fr, cl = wc * 32 + 8 * fq; const bool isk = u.pn < pn0;
        bf16_t* ob = isk ? KO + cl : O + (size_t)(u.pn - pn0) * pn_stride + cl; const int ld = isk ? 256 : ldc; const float sc = isk ? 1.0f : scale;
        const PG8_LAS float* rt = rstab + u.ui * 256 + wr * 64 + fr;
#pragma unroll
        for (int ai = 0; ai < 2; ++ai)
#pragma unroll
            for (int m = 0; m < 4; ++m) { const int row = row0 + ai * HALF + m * 16; const float r = rstab ? rt[ai * HALF + m * 16] * sc : sc;
#pragma unroll
                for (int bj = 0; bj < 2; ++bj) *(u32x4*)(ob + (size_t)row * ld + bj * HALF) = pack8(acc[ai][bj][m][0] * r, acc[ai][bj][m][1] * r); }
    }
};
struct EpiVT {
    static constexpr bool PERM = true, AFTER_DRAIN = true;
    bf16_t* O; int ld; const float* ssqp; size_t pm_stride, pn_stride;
    __device__ __forceinline__ void fused(f32x4 (&acc)[2][2][4][2], const Unit& u, int wr, int wc, int fr, int fq, PG8_LAS unsigned char* lds, int wid, int lane) const {
        PG8_LAS float* rs = (PG8_LAS float*)lds;
        { const int t = wid * 64 + lane, tok = t >> 1, half = t & 1; float r = 1.0f;
          if (ssqp) { const f32x4* p = (const f32x4*)(ssqp + (size_t)(u.pn * BM + tok) * 16 + half * 8); const f32x4 a = p[0], b = p[1], s4 = a + b; float s = (s4[0] + s4[1]) + (s4[2] + s4[3]);
              s += __shfl_xor(s, 1); r = __builtin_amdgcn_rsqf(s * (1.0f / 1024.0f) + 1e-5f); }
          if (half == 0) rs[tok] = r; }
        asm volatile("s_waitcnt lgkmcnt(0)" ::: "memory"); __builtin_amdgcn_s_barrier(); asm volatile("" ::: "memory");
        const int rl0 = wr * 64 + fr, cl = wc * 32 + 8 * fq; bf16_t* ob = O + (size_t)u.pm * pm_stride + (size_t)u.pn * pn_stride + cl;
#pragma unroll
        for (int bj = 0; bj < 2; ++bj) {
            const f32x4 s0 = *(const PG8_LAS f32x4*)(rs + bj * HALF + cl), s1 = *(const PG8_LAS f32x4*)(rs + bj * HALF + cl + 4);
#pragma unroll
            for (int ai = 0; ai < 2; ++ai)
#pragma unroll
                for (int m = 0; m < 4; ++m) *(u32x4*)(ob + (size_t)(rl0 + ai * HALF + m * 16) * ld + bj * HALF) = pack8(acc[ai][bj][m][0] * s0, acc[ai][bj][m][1] * s1);
        }
        asm volatile("s_waitcnt lgkmcnt(0)" ::: "memory"); __builtin_amdgcn_s_barrier(); asm volatile("" ::: "memory");
    }
};
struct EpiSwiglu {
    static constexpr bool PERM = true, AFTER_DRAIN = false;
    bf16_t* H; const PG8_LAS float* rstab;
    __device__ __forceinline__ void operator()(const f32x4 (&acc)[2][2][4][2], const Unit& u, int wr, int wc, int fr, int fq) const {
        const int row0 = u.pm * BM + wr * 64 + fr, cl = u.pn * 128 + wc * 32 + 8 * fq; const PG8_LAS float* rt = rstab + u.ui * 256 + wr * 64 + fr;
#pragma unroll
        for (int ai = 0; ai < 2; ++ai)
#pragma unroll
            for (int m = 0; m < 4; ++m) { const int row = row0 + ai * HALF + m * 16; const float r = rt[ai * HALF + m * 16], nr = r * -1.4426950408889634f, r2 = r * r;
                f32x4 hv[2];
#pragma unroll
                for (int n = 0; n < 2; ++n) { const f32x4 ag = acc[ai][0][m][n], au = acc[ai][1][m][n]; const f32x4 t = ag * nr, gu = (ag * au) * r2; f32x4 d;
#pragma unroll
                    for (int j = 0; j < 4; ++j) d[j] = __builtin_amdgcn_rcpf(1.0f + __builtin_amdgcn_exp2f(t[j]));
                    hv[n] = gu * d; }
                __builtin_nontemporal_store(pack8(hv[0], hv[1]), (u32x4*)(H + (size_t)row * 2816 + cl)); }
    }
};
struct EpiRes {
    static constexpr bool PERM = true, AFTER_DRAIN = false;
    bf16_t* xb; float* ssqp;
    __device__ __forceinline__ void operator()(const f32x4 (&acc)[2][2][4][2], const Unit& u, int wr, int wc, int fr, int fq) const {
        const int row0 = u.pm * BM + wr * 64 + fr, cl = u.pn * BM + wc * 32 + 8 * fq;
#pragma unroll
        for (int ai = 0; ai < 2; ++ai)
#pragma unroll
            for (int m = 0; m < 4; ++m) { const int row = row0 + ai * HALF + m * 16; bf16_t* xp = xb + (size_t)row * DMODEL + cl; float q = 0.f;
#pragma unroll
                for (int bj = 0; bj < 2; ++bj) { const u32x4 o = *(const u32x4*)(xp + bj * HALF);
                    const f32x4 b0 = {__builtin_bit_cast(float, o.x << 16), __builtin_bit_cast(float, o.x & 0xffff0000u), __builtin_bit_cast(float, o.y << 16), __builtin_bit_cast(float, o.y & 0xffff0000u)};
                    const f32x4 b1 = {__builtin_bit_cast(float, o.z << 16), __builtin_bit_cast(float, o.z & 0xffff0000u), __builtin_bit_cast(float, o.w << 16), __builtin_bit_cast(float, o.w & 0xffff0000u)};
                    const f32x4 x0 = b0 + acc[ai][bj][m][0], x1 = b1 + acc[ai][bj][m][1];
                    *(u32x4*)(xp + bj * HALF) = pack8(x0, x1);
                    q += (x0[0] * x0[0] + x0[1] * x0[1]) + (x0[2] * x0[2] + x0[3] * x0[3]) + (x1[0] * x1[0] + x1[1] * x1[1]) + (x1[2] * x1[2] + x1[3] * x1[3]); }
                q += __shfl_xor(q, 16); q += __shfl_xor(q, 32);
                if (fq == 0) ssqp[(size_t)row * 16 + u.pn * 4 + wc] = q; }
    }
};
template <class Epi, class Sched, bool ALIGN_EPI = false, bool SP2 = false>
__device__ __forceinline__ void gemm_phase(PG8_LAS unsigned char* lds, const Gemm g, const Sched& S, const Epi& E, const int tid) {
    const int wid = __builtin_amdgcn_readfirstlane(tid >> 6), lane = tid & 63, wr = wid >> 2, wc = wid & 3, fr = lane & 15, fq = lane >> 4;
    const int K = g.K, nt = K / BK;
    unsigned voffA[2], voffB[2];
#pragma unroll
    for (int i = 0; i < 2; ++i) { int R, C; stage_rc(tid * 16 + i * 8192, R, C); const int Rb = Epi::PERM ? ((R & ~31) + perm32(R & 31)) : R;
        voffA[i] = (unsigned)(R * K + C) * 2u; voffB[i] = (unsigned)(Rb * K + C) * 2u; }
    const size_t kstep = (size_t)(BK * 2);
    const size_t hstep = (size_t)HALF * K * 2;
    const size_t tstep = 2 * hstep;
    const unsigned ldsw = (unsigned)wid * 1024u;
    const int aoff = lds_byte(wr * 64 + fr, fq * 8), boff = lds_byte(wc * 32 + fr, fq * 8);
#define PG8_SA(b, h) (((b) * 2 + (h)) * HTB)
#define PG8_SB(b, h) ((4 + (b) * 2 + (h)) * HTB)
#define PG8_STAGE(bufoff, gbase, voff) do { _Pragma("unroll") for (int _i = 0; _i < 2; ++_i) \
        __builtin_amdgcn_global_load_lds((const unsigned*)((const char*)(gbase) + (voff)[_i]), (PG8_LAS unsigned*)(lds + (bufoff) + ldsw + _i * 8192), 16, 0, 0); } while (0)
#define PG8_LDA(dst, b, h) do { _Pragma("unroll") for (int m = 0; m < 4; ++m) _Pragma("unroll") for (int k = 0; k < 2; ++k) dst[m][k] = *(const PG8_LAS bf16x8*)(lds + PG8_SA(b, h) + aoff + m * 2048 + k * 1024); } while (0)
#define PG8_LDB(dst, b, h) do { _Pragma("unroll") for (int n = 0; n < 2; ++n) _Pragma("unroll") for (int k = 0; k < 2; ++k) dst[n][k] = *(const PG8_LAS bf16x8*)(lds + PG8_SB(b, h) + boff + n * 2048 + k * 1024); } while (0)
#define PG8_MMA(ai, bj, At, Bt) do { __builtin_amdgcn_s_setprio(1); _Pragma("unroll") for (int m = 0; m < 4; ++m) _Pragma("unroll") for (int n = 0; n < 2; ++n) _Pragma("unroll") for (int k = 0; k < 2; ++k) \
        acc[ai][bj][m][n] = __builtin_amdgcn_mfma_f32_16x16x32_bf16(Bt[n][k], At[m][k], acc[ai][bj][m][n], 0, 0, 0); __builtin_amdgcn_s_setprio(0); } while (0)
#define PG8_WAIT_V(n) asm volatile("s_waitcnt vmcnt(" #n ")" ::: "memory")
#define PG8_WAIT_L(n) asm volatile("s_waitcnt lgkmcnt(" #n ")" ::: "memory")
#define PG8_BAR __builtin_amdgcn_s_barrier()
#define PG8_SCHED __builtin_amdgcn_sched_barrier(0)
    Unit cur, nxt; int ui = 0;
    if (!S.next(0, cur)) return;
    f32x4 acc[2][2][4][2];
#pragma unroll
    for (int a = 0; a < 2; ++a)
#pragma unroll
        for (int b = 0; b < 2; ++b)
#pragma unroll
            for (int m = 0; m < 4; ++m)
#pragma unroll
                for (int n = 0; n < 2; ++n) acc[a][b][m][n] = (f32x4){0.f, 0.f, 0.f, 0.f};
    bf16x8 At[4][2], B0[2][2], B1[2][2];
    const char* cA = (const char*)g.A + (size_t)cur.pm * tstep; const char* cB = (const char*)g.Bt + (size_t)cur.pn * tstep;
    S.a_ready(cur);
    if constexpr (SP2) {
        PG8_STAGE(PG8_SB(0, 0), cB, voffB); PG8_STAGE(PG8_SB(0, 1), cB + hstep, voffB); PG8_STAGE(PG8_SA(0, 0), cA, voffA); PG8_STAGE(PG8_SA(0, 1), cA + hstep, voffA);
        if (wr == 1) PG8_BAR;
        PG8_WAIT_V(2); PG8_BAR;
        PG8_STAGE(PG8_SB(1, 0), cB + kstep, voffB); PG8_STAGE(PG8_SA(1, 0), cA + kstep, voffA); PG8_STAGE(PG8_SB(1, 1), cB + hstep + kstep, voffB);
        PG8_WAIT_V(6); PG8_BAR;
    } else {
        PG8_STAGE(PG8_SB(0, 0), cB, voffB); PG8_STAGE(PG8_SA(0, 0), cA, voffA); PG8_STAGE(PG8_SB(0, 1), cB + hstep, voffB); PG8_STAGE(PG8_SA(0, 1), cA + hstep, voffA);
        if (wr == 1) PG8_BAR;
        PG8_WAIT_V(4); PG8_BAR;
        PG8_STAGE(PG8_SB(1, 0), cB + kstep, voffB); PG8_STAGE(PG8_SA(1, 0), cA + kstep, voffA); PG8_STAGE(PG8_SB(1, 1), cB + hstep + kstep, voffB);
        PG8_WAIT_V(6); PG8_BAR;
    }
    for (;;) {
        const bool has_next = S.next(ui + 1, nxt);
        const char* nA = has_next ? (const char*)g.A + (size_t)nxt.pm * tstep : cA; const char* nB = has_next ? (const char*)g.Bt + (size_t)nxt.pn * tstep : cB;
        for (int t = 0; t < nt; t += 2) {
            const bool last = (t == nt - 2);
            const char* a1 = cA + (size_t)(t + 1) * kstep;
            const char* a2 = last ? nA : cA + (size_t)(t + 2) * kstep; const char* b2 = last ? nB : cB + (size_t)(t + 2) * kstep;
            const char* a3 = a2 + kstep; const char* b3 = b2 + kstep;
            if (last && has_next) S.a_ready(nxt);
            if constexpr (SP2) {
            PG8_LDB(B0, 0, 0); PG8_LDB(B1, 0, 1); PG8_SCHED; PG8_LDA(At, 0, 0); PG8_STAGE(PG8_SA(1, 1), a1 + hstep, voffA);
            PG8_WAIT_V(8); PG8_WAIT_L(0); PG8_BAR; PG8_MMA(0, 0, At, B0); PG8_MMA(0, 1, At, B1); PG8_BAR; PG8_SCHED;
            PG8_LDA(At, 0, 1); PG8_STAGE(PG8_SB(0, 0), b2, voffB); PG8_STAGE(PG8_SB(0, 1), b2 + hstep, voffB); PG8_STAGE(PG8_SA(0, 0), a2, voffA);
            PG8_WAIT_V(8); PG8_WAIT_L(0); PG8_BAR; PG8_MMA(1, 0, At, B0); PG8_MMA(1, 1, At, B1); PG8_BAR; PG8_SCHED;
            PG8_LDB(B0, 1, 0); PG8_LDB(B1, 1, 1); PG8_SCHED; PG8_LDA(At, 1, 0); PG8_STAGE(PG8_SA(0, 1), a2 + hstep, voffA);
            PG8_WAIT_V(8); PG8_WAIT_L(0); PG8_BAR; PG8_MMA(0, 0, At, B0); PG8_MMA(0, 1, At, B1); PG8_BAR; PG8_SCHED;
            PG8_LDA(At, 1, 1); PG8_STAGE(PG8_SB(1, 0), b3, voffB); PG8_STAGE(PG8_SB(1, 1), b3 + hstep, voffB); PG8_STAGE(PG8_SA(1, 0), a3, voffA);
            PG8_WAIT_V(8); PG8_WAIT_L(0); PG8_BAR; PG8_MMA(1, 0, At, B0); PG8_MMA(1, 1, At, B1); PG8_BAR; PG8_SCHED;
            } else {
            PG8_LDB(B0, 0, 0); PG8_SCHED; PG8_LDA(At, 0, 0); PG8_STAGE(PG8_SA(1, 1), a1 + hstep, voffA);
            PG8_WAIT_L(8); PG8_BAR; PG8_WAIT_L(0); PG8_MMA(0, 0, At, B0); PG8_BAR; PG8_SCHED;
            PG8_LDB(B1, 0, 1); PG8_STAGE(PG8_SB(0, 0), b2, voffB);
            PG8_BAR; PG8_WAIT_L(0); PG8_MMA(0, 1, At, B1); PG8_BAR;
            PG8_LDA(At, 0, 1); PG8_STAGE(PG8_SA(0, 0), a2, voffA);
            PG8_BAR; PG8_WAIT_L(0); PG8_MMA(1, 0, At, B0); PG8_BAR; PG8_SCHED;
            PG8_STAGE(PG8_SB(0, 1), b2 + hstep, voffB);
            PG8_WAIT_V(6); PG8_BAR; PG8_MMA(1, 1, At, B1); PG8_BAR;
            PG8_LDB(B0, 1, 0); PG8_SCHED; PG8_LDA(At, 1, 0); PG8_STAGE(PG8_SA(0, 1), a2 + hstep, voffA);
            PG8_WAIT_L(8); PG8_BAR; PG8_WAIT_L(0); PG8_MMA(0, 0, At, B0); PG8_BAR; PG8_SCHED;
            PG8_LDB(B1, 1, 1); PG8_STAGE(PG8_SB(1, 0), b3, voffB);
            PG8_BAR; PG8_WAIT_L(0); PG8_MMA(0, 1, At, B1); PG8_BAR;
            PG8_LDA(At, 1, 1); PG8_STAGE(PG8_SA(1, 0), a3, voffA);
            PG8_BAR; PG8_WAIT_L(0); PG8_MMA(1, 0, At, B0); PG8_BAR; PG8_SCHED;
            PG8_STAGE(PG8_SB(1, 1), b3 + hstep, voffB);
            PG8_WAIT_V(6); PG8_BAR; PG8_MMA(1, 1, At, B1); PG8_BAR;
            }
        }
        if constexpr (ALIGN_EPI) { if (wr == 0) PG8_BAR; }
        if constexpr (!Epi::AFTER_DRAIN) { E(acc, cur, wr, wc, fr, fq); S.done(cur); }
        if (!has_next) break;
#pragma unroll
        for (int a = 0; a < 2; ++a)
#pragma unroll
            for (int b = 0; b < 2; ++b)
#pragma unroll
                for (int m = 0; m < 4; ++m)
#pragma unroll
                    for (int n = 0; n < 2; ++n) acc[a][b][m][n] = (f32x4){0.f, 0.f, 0.f, 0.f};
        cur = nxt; cA = nA; cB = nB; ++ui;
        if constexpr (ALIGN_EPI) { if (wr == 1) PG8_BAR; }
    }
    PG8_WAIT_V(0);
    if constexpr (!ALIGN_EPI) { if (wr == 0) PG8_BAR; }
    PG8_BAR;
    if constexpr (Epi::AFTER_DRAIN) { E.fused(acc, cur, wr, wc, fr, fq, lds, wid, lane); S.done(cur); }
#undef PG8_SA
#undef PG8_SB
#undef PG8_STAGE
#undef PG8_LDA
#undef PG8_LDB
#undef PG8_MMA
#undef PG8_WAIT_V
#undef PG8_WAIT_L
#undef PG8_BAR
#undef PG8_SCHED
}
}

constexpr int BATCH = 2, SEQ = 16384, D = 1024, M = BATCH * SEQ, NMEM = 256, DFF = 2816, CONVW = 768, APROJ = 2560;
constexpr int NWAVES = 8, NTHREADS = 512;
constexpr float LOG2E = 1.4426950408889634f, QSCALE = 0.125f * LOG2E, EPS = 1e-5f;

constexpr size_t MiB = 1u << 20;
constexpr size_t WS_SSQ = 0;
constexpr size_t WS_MEMN = 2 * MiB;
constexpr size_t WS_MK = 3 * MiB;
constexpr size_t WS_MVT = 4 * MiB;
constexpr size_t WS_WAIN = 5 * MiB;
constexpr size_t WS_WAOUT = 15 * MiB;
constexpr size_t WS_WKV = 19 * MiB;
constexpr size_t WS_WBQ = 20 * MiB;
constexpr size_t WS_WBOUT = 24 * MiB;
constexpr size_t WS_WMEMKV = 28 * MiB;
constexpr size_t WS_WUP = 32 * MiB;
constexpr size_t WS_WDOWN = 76 * MiB;
constexpr size_t WS_XB = 98 * MiB;
constexpr size_t WS_KB = 162 * MiB;
constexpr size_t WS_VT = 178 * MiB;
constexpr size_t WS_H = 194 * MiB;
constexpr size_t WS_V = WS_H;
constexpr size_t WS_BG = WS_H + 48 * MiB;
constexpr size_t WS_QM = WS_H + 96 * MiB;
constexpr size_t WS_Y = WS_H + 112 * MiB;
constexpr size_t WS_Q = WS_H;
constexpr size_t WS_CTL = 370 * MiB, CTL_BYTES = 65536;
constexpr size_t WS_END = 371 * MiB;

constexpr int LDS_BYTES = 147456;
#define LAS __attribute__((address_space(3)))
typedef unsigned short bf16;
typedef unsigned v4u __attribute__((ext_vector_type(4)));
typedef unsigned v2u __attribute__((ext_vector_type(2)));
typedef float f32x4 __attribute__((ext_vector_type(4)));
typedef float f32x16 __attribute__((ext_vector_type(16)));
typedef short bf16x8 __attribute__((ext_vector_type(8)));
typedef short s16x4 __attribute__((ext_vector_type(4)));
#define LDS_WAIT() asm volatile("s_waitcnt lgkmcnt(0)" ::: "memory")
__device__ __forceinline__ unsigned f2bf(float f) { unsigned u = __builtin_bit_cast(unsigned, f); return (u + 0x7fffu + ((u >> 16) & 1u)) >> 16; }
__device__ __forceinline__ unsigned pk2(float lo, float hi) { return pg8::cvt_pk_bf16(lo, hi); }
__device__ __forceinline__ float bflo(unsigned u) { return __builtin_bit_cast(float, u << 16); }
__device__ __forceinline__ float bfhi(unsigned u) { return __builtin_bit_cast(float, u & 0xffff0000u); }
__device__ __forceinline__ float wave_sum(float v) {
#pragma unroll
    for (int o = 1; o < 64; o <<= 1) v += __shfl_xor(v, o);
    return v;
}

struct Args { const float* in[19]; float* out; unsigned char* ws; };
typedef const Args __attribute__((address_space(4)))* CArgsP;
__device__ __forceinline__ CArgsP kargs() { CArgsP p = (CArgsP)__builtin_amdgcn_kernarg_segment_ptr(); asm volatile("" : "+s"(p)); return p; }
enum { I_X = 0, I_MEM, I_NORM_MIX, I_NORM_FFN, I_A_W_IN, I_A_CONV_W, I_A_W_OUT, I_KV_NORM, I_W_KV, I_B_W_Q, I_B_SINKS, I_B_W_OUT, I_REL_BIAS, I_MEM_NORM, I_W_MEM_KV, I_W_GATE, I_W_UP, I_W_DOWN, I_FINAL_NORM };

template <bool HAS_GAIN>
__device__ __forceinline__ void transpose_item(const float* W, int K, int Nsrc, const float* gain, bf16* WT, int dst_row0, int k0, int n0, LAS float* scr, int lane) {
    const int c = lane & 7;
    f32x4 g0 = {1.f, 1.f, 1.f, 1.f}, g1 = {1.f, 1.f, 1.f, 1.f};
    if (HAS_GAIN) { g0 = *(const f32x4*)(gain + k0 + 8 * c); g1 = *(const f32x4*)(gain + k0 + 8 * c + 4); }
#pragma unroll
    for (int i = 0; i < 32; ++i) { const int kk = 2 * i + (lane >> 5); scr[kk * 33 + (lane & 31)] = __builtin_nontemporal_load(W + (size_t)(k0 + kk) * Nsrc + n0 + (lane & 31)); }
    LDS_WAIT(); asm volatile("" ::: "memory");
#pragma unroll
    for (int j = 0; j < 4; ++j) { const int n = (lane >> 3) + 8 * j; const LAS float* s = scr + (8 * c) * 33 + n;
        v4u o; o.x = pk2(s[0 * 33] * g0[0], s[1 * 33] * g0[1]); o.y = pk2(s[2 * 33] * g0[2], s[3 * 33] * g0[3]); o.z = pk2(s[4 * 33] * g1[0], s[5 * 33] * g1[1]); o.w = pk2(s[6 * 33] * g1[2], s[7 * 33] * g1[3]);
        *(v4u*)(WT + (size_t)(dst_row0 + n) * K + k0 + 8 * c) = o; }
    LDS_WAIT(); asm volatile("" ::: "memory");
}
__device__ __forceinline__ void prologue(LAS unsigned char* lds, int gw, int NGW, int wave, int lane) {
    const CArgsP ka = kargs(); unsigned char* ws = ka->ws;
    LAS float* scr = (LAS float*)(lds + wave * 16384);
    constexpr int N_AIN = 16 * 80, N_SQ = 16 * 32, N_KV = 16 * 16, N_FF = 16 * 88, N_DN = 44 * 32;
    constexpr int NITEMS = 2 * N_AIN + 2 * N_SQ + N_KV + 2 * N_SQ + 2 * N_SQ + 4 * N_KV + 4 * N_FF + 4 * N_FF + 4 * N_DN;
    for (int it = gw; it < NITEMS; it += NGW) {
        int r = it;
        if (r < 2 * N_AIN) { const int l = r / N_AIN; r %= N_AIN; const int kb = r / 80, nb = r % 80, n0 = 32 * nb;
            int dst; if (n0 < 768) dst = 256 * (n0 / 128) + (n0 % 128); else if (n0 < 1536) dst = 1536 + (n0 - 768); else if (n0 < 2304) dst = 256 * ((n0 - 1536) / 128) + 128 + ((n0 - 1536) % 128); else dst = n0;
            transpose_item<true>(ka->in[I_A_W_IN] + (size_t)l * D * APROJ, D, APROJ, ka->in[I_NORM_MIX] + l * D, (bf16*)(ws + WS_WAIN) + (size_t)l * APROJ * D, dst, 64 * kb, n0, scr, lane); continue; }
        r -= 2 * N_AIN;
        if (r < 2 * N_SQ) { const int l = r / N_SQ; r %= N_SQ; const int kb = r / 32, nb = r % 32;
            transpose_item<false>(ka->in[I_A_W_OUT] + (size_t)l * D * D, D, D, nullptr, (bf16*)(ws + WS_WAOUT) + (size_t)l * D * D, 32 * nb, 64 * kb, 32 * nb, scr, lane); continue; }
        r -= 2 * N_SQ;
        if (r < N_KV) { const int kb = r / 16, nb = r % 16;
            transpose_item<true>(ka->in[I_W_KV], D, 512, ka->in[I_KV_NORM], (bf16*)(ws + WS_WKV), (nb < 8 ? 256 + 32 * nb : 32 * (nb - 8)), 64 * kb, 32 * nb, scr, lane); continue; }
        r -= N_KV;
        if (r < 2 * N_SQ) { const int l = r / N_SQ; r %= N_SQ; const int kb = r / 32, nb = r % 32;
            transpose_item<true>(ka->in[I_B_W_Q] + (size_t)l * D * D, D, D, ka->in[I_NORM_MIX] + (2 + l) * D, (bf16*)(ws + WS_WBQ) + (size_t)l * D * D, 32 * nb, 64 * kb, 32 * nb, scr, lane); continue; }
        r -= 2 * N_SQ;
        if (r < 2 * N_SQ) { const int l = r / N_SQ; r %= N_SQ; const int kb = r / 32, nb = r % 32;
            transpose_item<false>(ka->in[I_B_W_OUT] + (size_t)l * D * D, D, D, nullptr, (bf16*)(ws + WS_WBOUT) + (size_t)l * D * D, 32 * nb, 64 * kb, 32 * nb, scr, lane); continue; }
        r -= 2 * N_SQ;
        if (r < 4 * N_KV) { const int l = r / N_KV; r %= N_KV; const int kb = r / 16, nb = r % 16;
            transpose_item<false>(ka->in[I_W_MEM_KV] + (size_t)l * D * 512, D, 512, nullptr, (bf16*)(ws + WS_WMEMKV), (nb < 8 ? 256 * l + 32 * nb : 1024 + 256 * l + 32 * (nb - 8)), 64 * kb, 32 * nb, scr, lane); continue; }
        r -= 4 * N_KV;
        if (r < 8 * N_FF) { const int which = r / (4 * N_FF); r %= 4 * N_FF; const int l = r / N_FF; r %= N_FF; const int kb = r / 88, nb = r % 88, n0 = 32 * nb;
            const int dst = 256 * (n0 / 128) + 128 * which + (n0 % 128);
            transpose_item<true>((which ? ka->in[I_W_UP] : ka->in[I_W_GATE]) + (size_t)l * D * DFF, D, DFF, ka->in[I_NORM_FFN] + l * D, (bf16*)(ws + WS_WUP) + (size_t)l * 2 * DFF * D, dst, 64 * kb, n0, scr, lane); continue; }
        r -= 8 * N_FF;
        { const int l = r / N_DN; r %= N_DN; const int kb = r / 32, nb = r % 32;
            transpose_item<false>(ka->in[I_W_DOWN] + (size_t)l * DFF * D, DFF, D, nullptr, (bf16*)(ws + WS_WDOWN) + (size_t)l * D * DFF, 32 * nb, 64 * kb, 32 * nb, scr, lane); }
    }
    const float* x = ka->in[I_X]; bf16* XB = (bf16*)(ws + WS_XB); float* ssqp = (float*)(ws + WS_SSQ);
    for (int m0 = gw; m0 < M; m0 += 4 * NGW) {
        f32x4 v[4][4];
#pragma unroll
        for (int q = 0; q < 4; ++q) { const f32x4* xr = (const f32x4*)(x + (size_t)(m0 + q * NGW) * D) + lane;
#pragma unroll
            for (int j = 0; j < 4; ++j) v[q][j] = __builtin_nontemporal_load(xr + 64 * j); }
#pragma unroll
        for (int q = 0; q < 4; ++q) { const int m = m0 + q * NGW; float s = 0.f;
#pragma unroll
            for (int j = 0; j < 4; ++j) s += (v[q][j].x * v[q][j].x + v[q][j].y * v[q][j].y) + (v[q][j].z * v[q][j].z + v[q][j].w * v[q][j].w);
            s = wave_sum(s);
            unsigned long long* o8 = (unsigned long long*)(XB + (size_t)m * D) + lane;
#pragma unroll
            for (int j = 0; j < 4; ++j) o8[64 * j] = (unsigned long long)pk2(v[q][j].x, v[q][j].y) | ((unsigned long long)pk2(v[q][j].z, v[q][j].w) << 32);
            if (lane < 16) ssqp[(size_t)m * 16 + lane] = lane == 0 ? s : 0.f; }
    }
    const float* mem = ka->in[I_MEM]; const float* mg = ka->in[I_MEM_NORM]; bf16* MEMN = (bf16*)(ws + WS_MEMN);
    for (int m = gw; m < BATCH * NMEM; m += NGW) {
        const f32x4* xr = (const f32x4*)(mem + (size_t)m * D) + lane; const f32x4* gr = (const f32x4*)mg + lane; f32x4 v[4]; float s = 0.f;
#pragma unroll
        for (int j = 0; j < 4; ++j) { v[j] = xr[64 * j]; s += (v[j].x * v[j].x + v[j].y * v[j].y) + (v[j].z * v[j].z + v[j].w * v[j].w); }
        const float rstd = 1.0f / sqrtf(wave_sum(s) * (1.0f / D) + EPS);
        unsigned long long* o8 = (unsigned long long*)(MEMN + (size_t)m * D) + lane;
#pragma unroll
        for (int j = 0; j < 4; ++j) { const f32x4 g = gr[64 * j]; const f32x4 y = v[j] * rstd * g; o8[64 * j] = (unsigned long long)pk2(y.x, y.y) | ((unsigned long long)pk2(y.z, y.w) << 32); }
    }
}

__device__ __forceinline__ unsigned cvtpk(float lo, float hi) { return pg8::cvt_pk_bf16(lo, hi); }
__device__ __forceinline__ void softmax_block(f32x16& S, float& m, float& l, f32x16& o0, f32x16& o1, bf16x8& p0, bf16x8& p1) {
    float bm = fmaxf(S[0], S[1]);
#pragma unroll
    for (int i = 2; i < 16; ++i) bm = fmaxf(bm, S[i]);
    bm = fmaxf(bm, __shfl_xor(bm, 32));
    const float mn = fmaxf(m, bm);
    const float alpha = __builtin_amdgcn_exp2f(m - mn);
    m = mn;
    float sum = 0.f;
#pragma unroll
    for (int i = 0; i < 16; ++i) { S[i] = __builtin_amdgcn_exp2f(S[i] - mn); sum += S[i]; }
    l = l * alpha + sum;
#pragma unroll
    for (int i = 0; i < 16; ++i) { o0[i] *= alpha; o1[i] *= alpha; }
    v4u w0, w1;
    w0.x = cvtpk(S[0], S[1]); w0.y = cvtpk(S[2], S[3]); w0.z = cvtpk(S[4], S[5]); w0.w = cvtpk(S[6], S[7]);
    w1.x = cvtpk(S[8], S[9]); w1.y = cvtpk(S[10], S[11]); w1.z = cvtpk(S[12], S[13]); w1.w = cvtpk(S[14], S[15]);
    p0 = __builtin_bit_cast(bf16x8, w0); p1 = __builtin_bit_cast(bf16x8, w1);
}
__device__ __forceinline__ void attn_store(const f32x16& o0, const f32x16& o1, float l, bf16* yrow, int hi) {
    l += __shfl_xor(l, 32);
    const float inv = 1.0f / l;
#pragma unroll
    for (int g = 0; g < 4; ++g) {
        v2u w; w.x = pk2(o0[4 * g] * inv, o0[4 * g + 1] * inv); w.y = pk2(o0[4 * g + 2] * inv, o0[4 * g + 3] * inv); *(v2u*)(yrow + 8 * g + 4 * hi) = w;
        v2u z; z.x = pk2(o1[4 * g] * inv, o1[4 * g + 1] * inv); z.y = pk2(o1[4 * g + 2] * inv, o1[4 * g + 3] * inv); *(v2u*)(yrow + 32 + 8 * g + 4 * hi) = z;
    }
}
constexpr int KIMG_STRIDE = 144, VIMG_STRIDE = 528, KIMG_BYTES = 256 * KIMG_STRIDE, VIMG_BYTES = 64 * VIMG_STRIDE, TAB_OFF = KIMG_BYTES + VIMG_BYTES;
__device__ __forceinline__ void mem_stage(LAS unsigned char* lds, const bf16* MK, const bf16* MVT, int layer, int b, int h, int tid) {
    const bf16* ksrc = MK + ((size_t)layer * 512 + b * 256) * 256 + h * 64;
    for (int i = tid; i < 256 * 8; i += NTHREADS) { const int key = i >> 3, c = i & 7; *(LAS v4u*)(lds + key * KIMG_STRIDE + c * 16) = *(const v4u*)(ksrc + (size_t)key * 256 + c * 8); }
    const bf16* vsrc = MVT + ((size_t)(layer * 2 + b) * 256 + h * 64) * 256;
    for (int i = tid; i < 64 * 32; i += NTHREADS) { const int d = i >> 5, c = i & 31; *(LAS v4u*)(lds + KIMG_BYTES + d * VIMG_STRIDE + c * 16) = *(const v4u*)(vsrc + (size_t)d * 256 + c * 8); }
    __syncthreads();
}
__device__ __forceinline__ void mem_attn_unit(LAS unsigned char* lds, const bf16* q, int ldq, bf16* y, int ldy, int lane) {
    const int r = lane & 31, hi = lane >> 5;
    bf16x8 qf[4];
#pragma unroll
    for (int s = 0; s < 4; ++s) qf[s] = __builtin_nontemporal_load((const bf16x8*)(q + (size_t)r * ldq + 16 * s + 8 * hi));
    float m = -1e30f, l = 0.f; f32x16 o0 = {}, o1 = {};
    for (int kb = 0; kb < 8; ++kb) {
        f32x16 S = {};
#pragma unroll
        for (int s = 0; s < 4; ++s) { const bf16x8 kf = *(const LAS bf16x8*)(lds + (kb * 32 + r) * KIMG_STRIDE + (16 * s + 8 * hi) * 2); S = __builtin_amdgcn_mfma_f32_32x32x16_bf16(kf, qf[s], S, 0, 0, 0); }
        bf16x8 p0, p1; softmax_block(S, m, l, o0, o1, p0, p1);
#pragma unroll
        for (int s = 0; s < 2; ++s) {
            const bf16x8 pb = s ? p1 : p0;
#pragma unroll
            for (int db = 0; db < 2; ++db) {
                const LAS unsigned char* vp = lds + KIMG_BYTES + (db * 32 + r) * VIMG_STRIDE + (kb * 32 + 16 * s + 4 * hi) * 2;
                const s16x4 a = *(const LAS s16x4*)vp, c = *(const LAS s16x4*)(vp + 16);
                const bf16x8 vf = (bf16x8){a[0], a[1], a[2], a[3], c[0], c[1], c[2], c[3]};
                if (db == 0) o0 = __builtin_amdgcn_mfma_f32_32x32x16_bf16(vf, pb, o0, 0, 0, 0); else o1 = __builtin_amdgcn_mfma_f32_32x32x16_bf16(vf, pb, o1, 0, 0, 0);
            }
        }
    }
    attn_store(o0, o1, l, y + (size_t)r * ldy, hi);
}
__device__ __forceinline__ void mem_attn_phase(LAS unsigned char* lds, const bf16* MK, const bf16* MVT, int layer, const bf16* Q, int ldq, int qcol0, bf16* Y, int tid, int wave, int lane) {
    const int G = gridDim.x, bh = blockIdx.x & 7, b = bh >> 2, h = bh & 3, slot = blockIdx.x >> 3, nslots = (G - bh + 7) >> 3;
    mem_stage(lds, MK, MVT, layer, b, h, tid);
    for (int g = slot * NWAVES + wave; g < SEQ / 32; g += nslots * NWAVES) {
        const size_t row0 = (size_t)b * SEQ + (size_t)g * 32;
        mem_attn_unit(lds, Q + row0 * ldq + qcol0 + h * 64, ldq, Y + row0 * D + CONVW + h * 64, D, lane);
    }
    __syncthreads();
}

__device__ __forceinline__ void conv_phase(const bf16* V, const bf16* BG, const float* cw, bf16* Y, int gtid, int nthreads) {
    constexpr int NCH = CONVW / 8;
    for (int idx = gtid; idx < (M / 4) * NCH; idx += nthreads) {
        const int rg = idx / NCH, ch = idx % NCH, c0 = ch * 8, t0 = rg * 4, tl = t0 % SEQ;
        float w0[8], w1[8], w2[8];
#pragma unroll
        for (int j = 0; j < 8; j += 4) { const f32x4 a = *(const f32x4*)(cw + c0 + j), b = *(const f32x4*)(cw + CONVW + c0 + j), c = *(const f32x4*)(cw + 2 * CONVW + c0 + j);
#pragma unroll
            for (int e = 0; e < 4; ++e) { w0[j + e] = a[e]; w1[j + e] = b[e]; w2[j + e] = c[e]; } }
        float vm2[8], vm1[8];
        if (tl != 0) { const v4u a = *(const v4u*)(V + (size_t)(t0 - 2) * CONVW + c0), b = *(const v4u*)(V + (size_t)(t0 - 1) * CONVW + c0);
#pragma unroll
            for (int e = 0; e < 4; ++e) { vm2[2 * e] = bflo(a[e]); vm2[2 * e + 1] = bfhi(a[e]); vm1[2 * e] = bflo(b[e]); vm1[2 * e + 1] = bfhi(b[e]); } }
        else {
#pragma unroll
            for (int e = 0; e < 8; ++e) { vm2[e] = 0.f; vm1[e] = 0.f; } }
#pragma unroll
        for (int rr = 0; rr < 4; ++rr) {
            const v4u vv = __builtin_nontemporal_load((const v4u*)(V + (size_t)(t0 + rr) * CONVW + c0)), gg = __builtin_nontemporal_load((const v4u*)(BG + (size_t)(t0 + rr) * CONVW + c0));
            float v[8], g[8], yv[8];
#pragma unroll
            for (int e = 0; e < 4; ++e) { v[2 * e] = bflo(vv[e]); v[2 * e + 1] = bfhi(vv[e]); g[2 * e] = bflo(gg[e]); g[2 * e + 1] = bfhi(gg[e]); }
#pragma unroll
            for (int e = 0; e < 8; ++e) { yv[e] = g[e] * (w0[e] * vm2[e] + w1[e] * vm1[e] + w2[e] * v[e]); vm2[e] = vm1[e]; vm1[e] = v[e]; }
            v4u o; o.x = pk2(yv[0], yv[1]); o.y = pk2(yv[2], yv[3]); o.z = pk2(yv[4], yv[5]); o.w = pk2(yv[6], yv[7]);
            *(v4u*)(Y + (size_t)(t0 + rr) * D + c0) = o;
        }
    }
}

constexpr int SK_STRIDE = 144, SK_BYTES = 384 * SK_STRIDE, SV_STRIDE = 776, SV_BYTES = 64 * SV_STRIDE, STAB_OFF = SK_BYTES + SV_BYTES;
static_assert(STAB_OFF + 12 * 128 * 4 <= 131072, "swa LDS map");
__device__ __forceinline__ void swa_unit(LAS unsigned char* lds, const LAS float* tab, const bf16* Q, bf16* Y, size_t row0, int tl0, int w, int qh, float sink2, int lane) {
    const int r = lane & 31, hi = lane >> 5;
    bf16x8 qf[4];
#pragma unroll
    for (int s = 0; s < 4; ++s) qf[s] = __builtin_nontemporal_load((const bf16x8*)(Q + (row0 + r) * D + qh * 64 + 16 * s + 8 * hi));
    float m = sink2, l = hi == 0 ? 1.0f : 0.0f; f32x16 o0 = {}, o1 = {};
    const LAS float* tb = tab + qh * 128;
    const int kb0 = tl0 >= 128 ? 0 : (128 - tl0) >> 5;
    for (int kb = kb0; kb < 5; ++kb) {
        const int j0 = 32 * w + 32 * kb;
        f32x16 S = {};
#pragma unroll
        for (int s = 0; s < 4; ++s) { const bf16x8 kf = *(const LAS bf16x8*)(lds + (j0 + r) * SK_STRIDE + (16 * s + 8 * hi) * 2); S = __builtin_amdgcn_mfma_f32_32x32x16_bf16(kf, qf[s], S, 0, 0, 0); }
#pragma unroll
        for (int i = 0; i < 16; ++i) { const int krow = (i & 3) + 8 * (i >> 2) + 4 * hi; const int dist = 128 - 32 * kb + r - krow;
            S[i] = ((unsigned)dist < 128u) ? S[i] + tb[dist & 127] : -1e30f; }
        bf16x8 p0, p1; softmax_block(S, m, l, o0, o1, p0, p1);
#pragma unroll
        for (int s = 0; s < 2; ++s) {
            const bf16x8 pb = s ? p1 : p0;
#pragma unroll
            for (int db = 0; db < 2; ++db) {
                const LAS unsigned char* vp = lds + SK_BYTES + (db * 32 + r) * SV_STRIDE + (j0 + 16 * s + 4 * hi) * 2;
                const s16x4 a = *(const LAS s16x4*)vp, c = *(const LAS s16x4*)(vp + 16);
                const bf16x8 vf = (bf16x8){a[0], a[1], a[2], a[3], c[0], c[1], c[2], c[3]};
                if (db == 0) o0 = __builtin_amdgcn_mfma_f32_32x32x16_bf16(vf, pb, o0, 0, 0, 0); else o1 = __builtin_amdgcn_mfma_f32_32x32x16_bf16(vf, pb, o1, 0, 0, 0);
            }
        }
    }
    attn_store(o0, o1, l, Y + (row0 + r) * D + qh * 64, hi);
}
__device__ __forceinline__ void swa_phase(LAS unsigned char* lds, const float* rel_bias, const float* sinks, const bf16* Q, const bf16* KB, const bf16* VT, bf16* Y, int tid, int wave, int lane) {
    LAS float* tab = (LAS float*)(lds + STAB_OFF);
    for (int i = tid; i < 12 * 128; i += NTHREADS) { const int h = i >> 7, d = i & 127;
        int bucket = d; if (d >= 16) { bucket = 16 + (int)(log2f((float)d * (1.0f / 16.0f)) * (16.0f / 3.0f)); bucket = bucket > 31 ? 31 : bucket; }
        tab[i] = rel_bias[bucket * 12 + h] * LOG2E; }
    const int G = gridDim.x;
    for (int task = blockIdx.x; task < 4 * (M / 256); task += G) {
        const int kvh = task & 3, chunk = task >> 2, b = chunk / (SEQ / 256), tlc = (chunk % (SEQ / 256)) * 256;
        __syncthreads();
        const int jlo = tlc == 0 ? 128 : 0;
        const bf16* ksrc = KB + ((size_t)b * SEQ + tlc - 128) * 256 + kvh * 64;
        for (int i = tid; i < 384 * 8; i += NTHREADS) { const int j = i >> 3, c = i & 7; if (j >= jlo) *(LAS v4u*)(lds + j * SK_STRIDE + c * 16) = *(const v4u*)(ksrc + (size_t)j * 256 + c * 8); }
        const bf16* vsrc = VT + (size_t)(kvh * 64) * M + (size_t)b * SEQ + tlc - 128;
        for (int i = tid; i < 64 * 96; i += NTHREADS) { const int d = i / 96, c = i % 96; if (c * 4 >= jlo) *(LAS v2u*)(lds + SK_BYTES + d * SV_STRIDE + c * 8) = *(const v2u*)(vsrc + (size_t)d * M + c * 4); }
        __syncthreads();
        const int tl0 = tlc + wave * 32; const size_t row0 = (size_t)b * SEQ + tl0;
        for (int g = 0; g < 3; ++g) { const int qh = kvh * 3 + g; swa_unit(lds, tab, Q, Y, row0, tl0, wave, qh, sinks[qh] * LOG2E, lane); }
    }
    __syncthreads();
}

__device__ __forceinline__ void final_phase(const bf16* XBs, float* out, const float* g, int gw, int NGW, int lane) {
    const f32x4* gr = (const f32x4*)g + lane;
    for (int m0 = gw; m0 < M; m0 += 4 * NGW) {
        v2u v[4][4];
#pragma unroll
        for (int q = 0; q < 4; ++q) { const v2u* xr = (const v2u*)(XBs + (size_t)(m0 + q * NGW) * D) + lane;
#pragma unroll
            for (int j = 0; j < 4; ++j) v[q][j] = __builtin_nontemporal_load(xr + 64 * j); }
#pragma unroll
        for (int q = 0; q < 4; ++q) { f32x4* orow = (f32x4*)(out + (size_t)(m0 + q * NGW) * D) + lane; f32x4 f[4]; float s = 0.f;
#pragma unroll
            for (int j = 0; j < 4; ++j) { f[j] = (f32x4){bflo(v[q][j].x), bfhi(v[q][j].x), bflo(v[q][j].y), bfhi(v[q][j].y)}; s += (f[j].x * f[j].x + f[j].y * f[j].y) + (f[j].z * f[j].z + f[j].w * f[j].w); }
            const float rstd = 1.0f / sqrtf(wave_sum(s) * (1.0f / D) + EPS);
#pragma unroll
            for (int j = 0; j < 4; ++j) __builtin_nontemporal_store(f[j] * rstd * gr[64 * j], orow + 64 * j); }
    }
}

#define XB_TMO      128
#define XB_XCNT(j)  (256  + 64 * (j))
#define XB_XSUB(j)  (1280 + 64 * (j))
#define XB_XGEN(j)  (2304 + 64 * (j))
#define XB_TOP      3328
#define XB_TOPGEN   3392
#define XCD_BAR_WORDS 3456
#define XB_SPIN_CAP (1u << 18)

__device__ __forceinline__ unsigned xb_ld(unsigned* p)              { return __hip_atomic_load(p, __ATOMIC_RELAXED, __HIP_MEMORY_SCOPE_AGENT); }
__device__ __forceinline__ unsigned xb_add(unsigned* p, unsigned v) { return __hip_atomic_fetch_add(p, v, __ATOMIC_RELAXED, __HIP_MEMORY_SCOPE_AGENT); }
__device__ __forceinline__ unsigned xb_xcc_id() { return (unsigned)__builtin_amdgcn_s_getreg((3 << 11) | 20) & 0xFu; }
#define XB_SPIN(cond, bar) do { unsigned _sp = 0; while (cond) { __builtin_amdgcn_s_sleep(1); \
    if ((++_sp & 255u) == 0u) { if (xb_ld(&(bar)[XB_TMO])) break; if (_sp > XB_SPIN_CAP) { atomicAdd(&(bar)[XB_TMO], 1u); break; } } } } while (0)

struct XcdBarrier {
    unsigned* bar; unsigned x;
    volatile LAS unsigned* st;
};

__device__ __forceinline__ XcdBarrier xcd_barrier_post(unsigned* bar, volatile LAS unsigned* st) {
    XcdBarrier b; b.bar = bar; b.x = xb_xcc_id(); b.st = st;
    if (threadIdx.x == 0) (void)xb_add(&bar[XB_XCNT(b.x)], 1u);
    return b;
}
__device__ __forceinline__ void xcd_barrier_complete(unsigned* bar, unsigned x, unsigned& nloc, unsigned& nx) {
    const unsigned G = gridDim.x * gridDim.y * gridDim.z;
    unsigned sum, cnt, mine, sp = 0u;
    for (;;) {
        sum = 0u; cnt = 0u; mine = 0u;
#pragma unroll
        for (unsigned j = 0; j < 16; ++j) { const unsigned c = xb_ld(&bar[XB_XCNT(j)]); sum += c; cnt += (c > 0u) ? 1u : 0u; mine = (j == x) ? c : mine; }
        if (sum == G) break;
        __builtin_amdgcn_s_sleep(1);
        if ((++sp & 255u) == 0u) { if (xb_ld(&bar[XB_TMO])) break; if (sp > XB_SPIN_CAP) { atomicAdd(&bar[XB_TMO], 1u); break; } }
    }
    nloc = mine > 0u ? mine : 1u; nx = cnt > 0u ? cnt : 1u;
}

__device__ __forceinline__ void xcd_barrier(const XcdBarrier& b) {
    asm volatile("s_waitcnt vmcnt(0)" ::: "memory");
    __syncthreads();
    if (threadIdx.x == 0) {
        unsigned* bar = b.bar;
        __builtin_amdgcn_s_waitcnt(0);
        unsigned nloc = b.st[0], nx = b.st[1];
        if (nloc == 0u) { xcd_barrier_complete(bar, b.x, nloc, nx); b.st[0] = nloc; b.st[1] = nx; }
        const unsigned old = xb_add(&bar[XB_XSUB(b.x)], 1u);
        const unsigned gen = old / nloc;
        if (old + 1u == (gen + 1u) * nloc) {
            __builtin_amdgcn_fence(__ATOMIC_RELEASE, "agent");
            asm volatile("s_waitcnt vmcnt(0)" ::: "memory");
            const unsigned og = xb_add(&bar[XB_TOP], 1u);
            const unsigned tg = og / nx;
            if (og + 1u == (tg + 1u) * nx) xb_add(&bar[XB_TOPGEN], 1u);
            else XB_SPIN(xb_ld(&bar[XB_TOPGEN]) == tg, bar);
            __builtin_amdgcn_fence(__ATOMIC_ACQUIRE, "agent");
            xb_add(&bar[XB_XGEN(b.x)], 1u);
            asm volatile("s_waitcnt vmcnt(0)" ::: "memory");
        } else {
            XB_SPIN(xb_ld(&bar[XB_XGEN(b.x)]) == gen, bar);
            __builtin_amdgcn_fence(__ATOMIC_ACQUIRE, "agent");
            asm volatile("s_waitcnt vmcnt(0)" ::: "memory");
        }
    }
    __syncthreads();
}

#define GRID_SYNC() do { XcdBarrier b_; b_.bar = (unsigned*)(kargs()->ws + WS_CTL); b_.x = xb_xcc_id(); b_.st = (volatile LAS unsigned*)(lds + 131072) + 8; xcd_barrier(b_); } while (0)
enum StepType { ST_AIN = 0, ST_MIXA, ST_RES, ST_UP, ST_KVQ, ST_ATTB, ST_FINAL };
__global__ void __launch_bounds__(NTHREADS, 2) yoco_fwd(Args a) {
    extern __shared__ __attribute__((aligned(16))) unsigned char lds_raw[];
    cg::grid_group grid = cg::this_grid();
    LAS unsigned char* lds = (LAS unsigned char*)lds_raw;
    const int tid = threadIdx.x, lane = tid & 63, wave = __builtin_amdgcn_readfirstlane(tid >> 6), G = gridDim.x;
    const int gw = blockIdx.x * NWAVES + wave, NGW = G * NWAVES;
    { unsigned char* ws = kargs()->ws;

    volatile LAS unsigned* MISC = (volatile LAS unsigned*)(lds + 131072);
    if (tid < 64) MISC[tid] = 0u;
    __syncthreads();
    (void)xcd_barrier_post((unsigned*)(ws + WS_CTL), MISC + 8);

    prologue(lds, gw, NGW, wave, lane);
    GRID_SYNC(); }

    for (int step = 0; step < 21; ++step) {
        int type, layer, sub = 0;
        if (step < 20) { layer = step / 5; const int k = step % 5; sub = (k == 4);
            type = (k == 0) ? (layer < 2 ? ST_AIN : ST_KVQ) : (k == 1) ? (layer < 2 ? ST_MIXA : ST_ATTB) : (k == 3) ? ST_UP : ST_RES; }
        else { type = ST_FINAL; layer = 3; }
        int tidv = threadIdx.x; asm volatile("" : "+v"(tidv));
        const int lanev = tidv & 63, wavev = __builtin_amdgcn_readfirstlane(tidv >> 6);
        const CArgsP ka = kargs(); unsigned char* ws = ka->ws;
        float* ssqp = (float*)(ws + WS_SSQ); bf16* XB = (bf16*)(ws + WS_XB); bf16* Hb = (bf16*)(ws + WS_H); bf16* Yb = (bf16*)(ws + WS_Y); bf16* MK = (bf16*)(ws + WS_MK); bf16* MVT = (bf16*)(ws + WS_MVT);
        switch (type) {
        case ST_AIN: {
            if (layer == 0) {
                { pg8::Gemm g{(const bf16*)(ws + WS_MEMN), (const bf16*)(ws + WS_WMEMKV), 512, 1024, D}; pg8::StaticOrder S; S.init(512, 1024, G, (int)blockIdx.x);
                  pg8::EpiRowScale E{MK, 256, (const LAS float*)nullptr, 1.0f, (size_t)512 * 256, nullptr, 0};
                  pg8::gemm_phase<pg8::EpiRowScale, pg8::StaticOrder, true, true>(lds, g, S, E, tidv); }
                { pg8::Gemm g{(const bf16*)(ws + WS_WMEMKV) + (size_t)1024 * D, (const bf16*)(ws + WS_MEMN), 1024, 512, D}; pg8::StaticOrder S; S.init(1024, 512, G, (int)((blockIdx.x + G - 8) % G));
                  pg8::EpiVT E{MVT, 256, nullptr, (size_t)2 * 65536, (size_t)65536};
                  pg8::gemm_phase<pg8::EpiVT, pg8::StaticOrder, true, true>(lds, g, S, E, tidv); }
            }
            pg8::Gemm g{XB, (const bf16*)(ws + WS_WAIN) + (size_t)layer * APROJ * D, M, APROJ, D}; pg8::StaticOrder S; S.init(M, APROJ, G, (int)blockIdx.x);
            pg8::fill_rstd(lds, ssqp, S, tidv);
            pg8::EpiAIn E{(bf16*)(ws + WS_V), (bf16*)(ws + WS_BG), (bf16*)(ws + WS_QM), (const LAS float*)(lds + pg8::RSTAB_OFF), QSCALE};
            pg8::gemm_phase<pg8::EpiAIn, pg8::StaticOrder, true, true>(lds, g, S, E, tidv);
        } break;
        case ST_MIXA: {
            conv_phase((const bf16*)(ws + WS_V), (const bf16*)(ws + WS_BG), ka->in[I_A_CONV_W] + (size_t)layer * 3 * CONVW, Yb, blockIdx.x * NTHREADS + tidv, G * NTHREADS);
            mem_attn_phase(lds, MK, MVT, layer, (const bf16*)(ws + WS_QM), 256, 0, Yb, tidv, wavev, lanev);
        } break;
        case ST_RES: {
            const bf16* A = sub ? Hb : Yb; const int K = sub ? DFF : D;
            const bf16* Bt = sub ? (const bf16*)(ws + WS_WDOWN) + (size_t)layer * D * DFF : (layer < 2 ? (const bf16*)(ws + WS_WAOUT) + (size_t)layer * D * D : (const bf16*)(ws + WS_WBOUT) + (size_t)(layer - 2) * D * D);
            pg8::Gemm g{A, Bt, M, D, K}; pg8::StaticOrder S; S.init(M, D, G, (int)blockIdx.x);
            pg8::EpiRes E{XB, ssqp};
            pg8::gemm_phase<pg8::EpiRes, pg8::StaticOrder, true, true>(lds, g, S, E, tidv);
        } break;
        case ST_UP: {
            pg8::Gemm g{XB, (const bf16*)(ws + WS_WUP) + (size_t)layer * 2 * DFF * D, M, 2 * DFF, D}; pg8::StaticOrder S; S.init(M, 2 * DFF, G, (int)blockIdx.x);
            pg8::fill_rstd(lds, ssqp, S, tidv);
            pg8::EpiSwiglu E{Hb, (const LAS float*)(lds + pg8::RSTAB_OFF)};
            pg8::gemm_phase<pg8::EpiSwiglu, pg8::StaticOrder, true, true>(lds, g, S, E, tidv);
        } break;
        case ST_KVQ: {
            if (layer == 2) {
                pg8::Gemm g{(const bf16*)(ws + WS_WKV), XB, 256, M, D}; pg8::StaticOrder S; S.init(256, M, G, (int)((blockIdx.x + G - 128) % G));
                pg8::EpiVT E{(bf16*)(ws + WS_VT), M, ssqp, (size_t)0, (size_t)256};
                pg8::gemm_phase<pg8::EpiVT, pg8::StaticOrder, true, true>(lds, g, S, E, tidv);
            }
            const int pn0 = layer == 2 ? 1 : 0;
            pg8::Gemm g{XB, layer == 2 ? (const bf16*)(ws + WS_WKV) + (size_t)256 * D : (const bf16*)(ws + WS_WBQ) + (size_t)D * D, M, D + 256 * pn0, D}; pg8::StaticOrder S; S.init(M, D + 256 * pn0, G, (int)blockIdx.x);
            pg8::fill_rstd(lds, ssqp, S, tidv);
            pg8::EpiRowScale E{(bf16*)(ws + WS_Q), D, (const LAS float*)(lds + pg8::RSTAB_OFF), QSCALE, (size_t)256, (bf16*)(ws + WS_KB), pn0};
            pg8::gemm_phase<pg8::EpiRowScale, pg8::StaticOrder, true, true>(lds, g, S, E, tidv);
        } break;
        case ST_ATTB: {
            swa_phase(lds, ka->in[I_REL_BIAS], ka->in[I_B_SINKS] + (layer - 2) * 12, (const bf16*)(ws + WS_Q), (const bf16*)(ws + WS_KB), (const bf16*)(ws + WS_VT), Yb, tidv, wavev, lanev);
            mem_attn_phase(lds, MK, MVT, layer, (const bf16*)(ws + WS_Q), D, CONVW, Yb, tidv, wavev, lanev);
        } break;
        default: {
            final_phase(XB, ka->out, ka->in[I_FINAL_NORM], blockIdx.x * NWAVES + wavev, NGW, lanev);
        } break;
        }
        if (step < 20) GRID_SYNC();
    }
    if (kargs()->out == nullptr) grid.sync();
}

extern "C" void kernel_launch(void* const* d_in, const int* in_sizes, int n_in, void* d_out, int out_size, void* d_ws, size_t ws_size, hipStream_t stream) {
    static int grid = 0;
    if (grid == 0) {
        if (n_in != 19 || out_size != M * D || ws_size < WS_END) { fprintf(stderr, "kernel_launch: unexpected shapes (n_in %d out %d ws %zu)\n", n_in, out_size, ws_size); grid = -1; return; }
        int dev = 0, cus = 0, per_cu = 0;
        if (hipGetDevice(&dev) != hipSuccess || hipDeviceGetAttribute(&cus, hipDeviceAttributeMultiprocessorCount, dev) != hipSuccess) { grid = -1; return; }
        if (hipFuncSetAttribute((const void*)yoco_fwd, hipFuncAttributeMaxDynamicSharedMemorySize, LDS_BYTES) != hipSuccess) { fprintf(stderr, "kernel_launch: hipFuncSetAttribute failed\n"); grid = -1; return; }
        if (hipOccupancyMaxActiveBlocksPerMultiprocessor(&per_cu, (const void*)yoco_fwd, NTHREADS, LDS_BYTES) != hipSuccess || per_cu < 1) per_cu = 1;
        (void)hipGetLastError();
        grid = cus * per_cu;
        if (grid != 256) { fprintf(stderr, "kernel_launch: built for a 256-workgroup grid (one per CU), got %d\n", grid); grid = -1; return; }
    }
    if (grid < 0) return;
    if (hipMemsetAsync((char*)d_ws + WS_CTL, 0, CTL_BYTES, stream) != hipSuccess) { fprintf(stderr, "kernel_launch: memset failed\n"); return; }
    Args a{};
    for (int i = 0; i < 19; ++i) a.in[i] = (const float*)d_in[i];
    a.out = (float*)d_out; a.ws = (unsigned char*)d_ws;
    void* args[] = {&a};
    const hipError_t e = hipLaunchCooperativeKernel((const void*)yoco_fwd, dim3(grid), dim3(NTHREADS), args, LDS_BYTES, stream);
    if (e != hipSuccess) fprintf(stderr, "kernel_launch: cooperative launch failed: %s (grid %d)\n", hipGetErrorString(e), grid);
}
```
